# Optimizing an MI355X kernel written in HIP

```python
import math
import jax, jax.numpy as jnp
from jax import lax
import numpy as np

D_MODEL = 1024
BATCH = 4
SEQ = 4096
DEPTH = 4
DEC_BATCH = 128
DEC_SEQ = 8
PAST_LEN = 2048
PAGE_SIZE = 128

N_EVEN = (DEPTH + 1) // 2
N_ODD = DEPTH // 2
EPS = 1e-6
CONV_CH = D_MODEL // 2
CONV_W = 31
HEAD_DIM = 64
HPG = 4
DIL_GROUPS = ((128, 1), (512, 4), (2048, 16))
N_DIL = len(DIL_GROUPS)
ATT_W = N_DIL * HPG * HEAD_DIM
ATT_OUT = HPG * HEAD_DIM
ROT_DIM = HEAD_DIM // 4
ROPE_THETA = 500000.0
BAND_BLOCK = 128
IN_COLS = 2 * CONV_CH + 3 * ATT_W
MIX_OUT = CONV_CH + ATT_OUT
S5_GROUP = 16
S5_GROUPS = D_MODEL // S5_GROUP
S5_STATE = 64
S5_CHUNK = 128
D_FF = int(math.ceil(8 * D_MODEL / 3 / 256)) * 256

kernel_name = 'hybrid_conv_dilattn_s5_adaln_step'


def rmsnorm(x, g):
    xf = x.astype(jnp.float32)
    y = xf * lax.rsqrt(jnp.mean(xf * xf, axis=-1, keepdims=True) + EPS)
    return (y * g.astype(jnp.float32)).astype(x.dtype)


def layernorm(x, g, b):
    xf = x.astype(jnp.float32)
    mu = jnp.mean(xf, axis=-1, keepdims=True)
    xc = xf - mu
    y = xc * lax.rsqrt(jnp.mean(xc * xc, axis=-1, keepdims=True) + EPS)
    return (y * g.astype(jnp.float32) + b.astype(jnp.float32)).astype(x.dtype)


def rope(x, pos):
    half = ROT_DIM // 2
    inv = jnp.float32(ROPE_THETA) ** (-(2.0 / ROT_DIM) * jnp.arange(half, dtype=jnp.float32))
    ang = pos.astype(jnp.float32)[:, None] * inv[None, :]
    bshape = (1, pos.shape[0]) + (1,) * (x.ndim - 3) + (half,)
    cos = jnp.cos(ang).reshape(bshape)
    sin = jnp.sin(ang).reshape(bshape)
    xr = x[..., :ROT_DIM].astype(jnp.float32)
    x1, x2 = xr[..., :half], xr[..., half:]
    rot = jnp.concatenate([x1 * cos - x2 * sin, x2 * cos + x1 * sin], axis=-1).astype(x.dtype)
    return jnp.concatenate([rot, x[..., ROT_DIM:]], axis=-1)


def dilated_attn_prompt(q, k, v, window, dil):
    n, s, h, dh = q.shape
    ls = s // dil
    bb = BAND_BLOCK
    nb = -(-ls // bb)
    lp = nb * bb
    span = window // dil

    def strided(t):
        t = t.reshape(n, ls, dil, h, dh).transpose(0, 2, 1, 3, 4)
        t = jnp.pad(t, ((0, 0), (0, 0), (0, lp - ls), (0, 0), (0, 0)))
        return t.reshape(n, dil, nb, bb, h, dh)

    def with_prev(t):
        prev = jnp.pad(t, ((0, 0), (0, 0), (1, 0), (0, 0), (0, 0), (0, 0)))[:, :, :nb]
        return jnp.concatenate([prev, t], axis=3)

    qs = strided(q)
    kb = with_prev(strided(k))
    vb = with_prev(strided(v))
    sc = jnp.einsum('nrbqhd,nrbkhd->nrbhqk', qs, kb).astype(jnp.float32)
    blk = jnp.arange(nb)[:, None, None] * bb
    qi = blk + jnp.arange(bb)[None, :, None]
    ki = blk - bb + jnp.arange(2 * bb)[None, None, :]
    dist = qi - ki
    mask = (ki >= 0) & (dist >= 0) & (dist <= span)
    sc = jnp.where(mask[None, None, :, None], sc, -jnp.inf)
    m = jnp.max(sc, axis=-1, keepdims=True)
    p = jnp.exp(sc - m)
    l = jnp.sum(p, axis=-1, keepdims=True)
    o = jnp.einsum('nrbhqk,nrbkhd->nrbqhd', p / l, vb.astype(jnp.float32))
    lse = (m + jnp.log(l))[..., 0]
    o = o.reshape(n, dil, lp, h, dh)[:, :, :ls].transpose(0, 2, 1, 3, 4).reshape(n, s, h, dh)
    lse = lse.transpose(0, 1, 2, 4, 3).reshape(n, dil, lp, h)[:, :, :ls]
    lse = lse.transpose(0, 2, 1, 3).reshape(n, s, h)
    return o, lse


def dilated_attn_sample(q, k, v, buf, window, dil):
    n, t, h, dh = q.shape
    wb = buf.shape[1]
    span = window // dil
    kf = jnp.concatenate([buf[:, :, 0].astype(k.dtype), k], axis=1)
    vf = jnp.concatenate([buf[:, :, 1].astype(v.dtype), v], axis=1)
    idx = wb + jnp.arange(t)[:, None] - dil * jnp.arange(span + 1)[None, :]
    valid = idx >= 0
    idx = jnp.maximum(idx, 0)
    kg = kf[:, idx]
    vg = vf[:, idx]
    sc = jnp.einsum('nthd,ntkhd->nthk', q, kg).astype(jnp.float32)
    sc = jnp.where(valid[None, :, None, :], sc, -jnp.inf)
    m = jnp.max(sc, axis=-1, keepdims=True)
    p = jnp.exp(sc - m)
    l = jnp.sum(p, axis=-1, keepdims=True)
    o = jnp.einsum('nthk,ntkhd->nthd', p / l, vg.astype(jnp.float32))
    lse = (m + jnp.log(l))[..., 0]
    return o, lse


def even_mixer(h, pos, conv_hist, kv_bufs, w_in, conv_w, conv_b, ln_g, ln_b, w_o):
    n, L, _ = h.shape
    z = h @ w_in
    a_val = z[..., :CONV_CH]
    a_gate = z[..., CONV_CH:2 * CONV_CH]
    qkv = z[..., 2 * CONV_CH:].reshape(n, L, 3, N_DIL, HPG, HEAD_DIM)
    u = a_val * jax.nn.sigmoid(a_gate)
    full = jnp.concatenate([conv_hist.astype(u.dtype), u], axis=1)
    yc = lax.conv_general_dilated(full, conv_w[:, None, :].astype(full.dtype), (1,), 'VALID',
                                  dimension_numbers=('NWC', 'WIO', 'NWC'),
                                  feature_group_count=CONV_CH) + conv_b
    yc = jax.nn.silu(layernorm(yc, ln_g, ln_b))
    new_hist = full[:, -(CONV_W - 1):]
    q = rope(qkv[:, :, 0], pos) * (HEAD_DIM ** -0.5)
    k = rope(qkv[:, :, 1], pos)
    v = qkv[:, :, 2]
    outs, lses, kv_new = [], [], []
    for gi, (win, dil) in enumerate(DIL_GROUPS):
        qg, kg, vg = q[:, :, gi], k[:, :, gi], v[:, :, gi]
        if kv_bufs is None:
            o, lse = dilated_attn_prompt(qg, kg, vg, win, dil)
            keep = min(win, L)
            kv_new.append(jnp.stack([kg[:, L - keep:], vg[:, L - keep:]], axis=2))
        else:
            o, lse = dilated_attn_sample(qg, kg, vg, kv_bufs[gi], win, dil)
            kv_new.append(jnp.stack([kg, vg], axis=2))
        outs.append(o)
        lses.append(lse)
    wts = jax.nn.softmax(jnp.stack(lses), axis=0)[..., None]
    att = jnp.sum(wts * jnp.stack(outs), axis=0).astype(h.dtype).reshape(n, L, ATT_OUT)
    mix = jnp.concatenate([yc.astype(h.dtype), att], axis=-1) @ w_o
    return mix, new_hist, kv_new


def complex_affine_combine(e1, e2):
    a1r, a1i, b1r, b1i = e1
    a2r, a2i, b2r, b2i = e2
    return (a2r * a1r - a2i * a1i, a2r * a1i + a2i * a1r,
            a2r * b1r - a2i * b1i + b2r, a2r * b1i + a2i * b1r + b2i)


def s5_mixer(u, s0, lam_re, lam_im, log_dt, b_re, b_im, c_re, c_im, d_skip, w_glu, b_glu):
    f32 = jnp.float32
    n, L, _ = u.shape
    ug = u.astype(f32).reshape(n, L, S5_GROUPS, S5_GROUP)
    lr = lam_re.astype(f32)
    li = lam_im.astype(f32)
    dt = jnp.exp(log_dt.astype(f32))[:, None]
    mag = jnp.exp(lr * dt)
    ph = li * dt
    ab_re = mag * jnp.cos(ph)
    ab_im = mag * jnp.sin(ph)
    den = lr * lr + li * li
    nr = ab_re - 1.0
    f_re = (nr * lr + ab_im * li) / den
    f_im = (ab_im * lr - nr * li) / den
    br = b_re.astype(f32)
    bi = b_im.astype(f32)
    bb_re = f_re[..., None] * br - f_im[..., None] * bi
    bb_im = f_re[..., None] * bi + f_im[..., None] * br
    cr = c_re.astype(f32)
    ci = c_im.astype(f32)
    chunk = S5_CHUNK if L % S5_CHUNK == 0 else L
    nc = L // chunk
    uc = ug.reshape(n, nc, chunk, S5_GROUPS, S5_GROUP).transpose(1, 0, 2, 3, 4)

    def step(carry, ub):
        sr, si = carry
        bur = jnp.einsum('ncgh,gph->ncgp', ub, bb_re)
        bui = jnp.einsum('ncgh,gph->ncgp', ub, bb_im)
        bur = bur.at[:, 0].add(ab_re * sr - ab_im * si)
        bui = bui.at[:, 0].add(ab_re * si + ab_im * sr)
        ar = jnp.broadcast_to(ab_re, bur.shape)
        ai = jnp.broadcast_to(ab_im, bur.shape)
        _, _, hr, hi = lax.associative_scan(complex_affine_combine, (ar, ai, bur, bui), axis=1)
        y = jnp.einsum('ncgp,ghp->ncgh', hr, cr) - jnp.einsum('ncgp,ghp->ncgh', hi, ci)
        return (hr[:, -1], hi[:, -1]), y

    s0f = s0.astype(f32)
    (sr, si), ys = lax.scan(step, (s0f[..., 0], s0f[..., 1]), uc)
    y = ys.transpose(1, 0, 2, 3, 4).reshape(n, L, D_MODEL) + d_skip.astype(f32) * u.astype(f32)
    zz = jax.nn.gelu(y)
    g = zz @ w_glu.astype(f32) + b_glu.astype(f32)
    out = g[..., :D_MODEL] * jax.nn.sigmoid(g[..., D_MODEL:])
    return out.astype(u.dtype), jnp.stack([sr, si], axis=-1)


def swiglu(h, wg, wu, wd):
    return (jax.nn.silu(h @ wg) * (h @ wu)) @ wd


def run_trunk(x, c, pos, conv_st, kv_st, s5_st, W):
    n = x.shape[0]
    new_conv, new_s5 = [], []
    new_kv = [[] for _ in range(N_DIL)]
    ei = 0
    oi = 0
    for layer in range(DEPTH):
        mod = jax.nn.silu(c.astype(jnp.float32)) @ W['w_ada'][layer].astype(jnp.float32)
        mod = (mod + W['b_ada'][layer].astype(jnp.float32)).astype(x.dtype)[:, None, :]
        sh1, sc1, g1, sh2, sc2, g2 = jnp.split(mod, 6, axis=-1)
        h = rmsnorm(x, W['norm_g'][layer, 0]) * (1 + sc1) + sh1
        if layer % 2 == 0:
            hist = jnp.zeros((n, CONV_W - 1, CONV_CH), x.dtype) if conv_st is None else conv_st[ei]
            bufs = None if kv_st is None else [kv[ei] for kv in kv_st]
            mix, hist_new, kv_new = even_mixer(h, pos, hist, bufs, W['w_in'][ei], W['conv_w'][ei],
                                               W['conv_b'][ei], W['conv_ln_g'][ei],
                                               W['conv_ln_b'][ei], W['w_o'][ei])
            new_conv.append(hist_new)
            for gi in range(N_DIL):
                new_kv[gi].append(kv_new[gi])
            ei += 1
        else:
            s0 = jnp.zeros((n, S5_GROUPS, S5_STATE, 2), jnp.float32) if s5_st is None else s5_st[oi]
            mix, s_new = s5_mixer(h, s0, W['s5_lam_re'][oi], W['s5_lam_im'][oi], W['s5_log_dt'][oi],
                                  W['s5_b_re'][oi], W['s5_b_im'][oi], W['s5_c_re'][oi],
                                  W['s5_c_im'][oi], W['s5_d'][oi], W['s5_w_glu'][oi],
                                  W['s5_b_glu'][oi])
            new_s5.append(s_new)
            oi += 1
        x = x + g1 * mix
        h = rmsnorm(x, W['norm_g'][layer, 1]) * (1 + sc2) + sh2
        x = x + g2 * swiglu(h, W['w_ff_gate'][layer], W['w_ff_up'][layer], W['w_ff_down'][layer])
    y = rmsnorm(x, W['final_g'])
    return y, jnp.stack(new_conv), [jnp.stack(kv) for kv in new_kv], jnp.stack(new_s5)


def setup_inputs(seed: int = 0) -> dict:
    key = jax.random.key(seed)
    ks = jax.random.split(key, 32)
    f32 = jnp.float32

    def nrm(i, shape, s):
        return jax.random.normal(ks[i], shape, f32) * s

    wb = [min(w, PAST_LEN) for (w, _) in DIL_GROUPS]
    lam_im0 = jnp.pi * jnp.arange(S5_STATE, dtype=f32)
    return {
        'x_prompt': nrm(0, (BATCH, SEQ, D_MODEL), 1.0),
        'x_sample': nrm(1, (DEC_BATCH, DEC_SEQ, D_MODEL), 1.0),
        'cache_conv': nrm(2, (N_EVEN, DEC_BATCH, CONV_W - 1, CONV_CH), 0.5),
        'cache_kv_g0': nrm(3, (N_EVEN, DEC_BATCH, wb[0], 2, HPG, HEAD_DIM), 1.0),
        'cache_kv_g1': nrm(4, (N_EVEN, DEC_BATCH, wb[1], 2, HPG, HEAD_DIM), 1.0),
        'cache_kv_g2': nrm(5, (N_EVEN, DEC_BATCH, wb[2], 2, HPG, HEAD_DIM), 1.0),
        'state_s5': nrm(6, (N_ODD, DEC_BATCH, S5_GROUPS, S5_STATE, 2), 1.0),
        'c_prompt': nrm(7, (BATCH, D_MODEL), 1.0),
        'c_sample': nrm(8, (DEC_BATCH, D_MODEL), 1.0),
        'norm_g': 1.0 + nrm(9, (DEPTH, 2, D_MODEL), 0.01),
        'final_g': 1.0 + nrm(10, (D_MODEL,), 0.01),
        'w_ada': nrm(11, (DEPTH, D_MODEL, 6 * D_MODEL), 0.5 * D_MODEL ** -0.5),
        'b_ada': nrm(12, (DEPTH, 6 * D_MODEL), 0.01),
        'w_in': nrm(13, (N_EVEN, D_MODEL, IN_COLS), D_MODEL ** -0.5),
        'conv_w': nrm(14, (N_EVEN, CONV_W, CONV_CH), CONV_W ** -0.5),
        'conv_b': nrm(15, (N_EVEN, CONV_CH), 0.01),
        'conv_ln_g': 1.0 + nrm(16, (N_EVEN, CONV_CH), 0.01),
        'conv_ln_b': nrm(17, (N_EVEN, CONV_CH), 0.01),
        'w_o': nrm(18, (N_EVEN, MIX_OUT, D_MODEL), MIX_OUT ** -0.5),
        's5_lam_re': -0.5 + nrm(19, (N_ODD, S5_GROUPS, S5_STATE), 0.01),
        's5_lam_im': lam_im0 + nrm(20, (N_ODD, S5_GROUPS, S5_STATE), 0.01),
        's5_log_dt': jax.random.uniform(ks[21], (N_ODD, S5_GROUPS), f32,
                                        minval=math.log(1e-3), maxval=math.log(1e-1)),
        's5_b_re': nrm(22, (N_ODD, S5_GROUPS, S5_STATE, S5_GROUP), (2 * S5_GROUP) ** -0.5),
        's5_b_im': nrm(23, (N_ODD, S5_GROUPS, S5_STATE, S5_GROUP), (2 * S5_GROUP) ** -0.5),
        's5_c_re': nrm(24, (N_ODD, S5_GROUPS, S5_GROUP, S5_STATE), S5_STATE ** -0.5),
        's5_c_im': nrm(25, (N_ODD, S5_GROUPS, S5_GROUP, S5_STATE), S5_STATE ** -0.5),
        's5_d': nrm(26, (N_ODD, D_MODEL), 1.0),
        's5_w_glu': nrm(27, (N_ODD, D_MODEL, 2 * D_MODEL), D_MODEL ** -0.5),
        's5_b_glu': nrm(28, (N_ODD, 2 * D_MODEL), 0.01),
        'w_ff_gate': nrm(29, (DEPTH, D_MODEL, D_FF), D_MODEL ** -0.5),
        'w_ff_up': nrm(30, (DEPTH, D_MODEL, D_FF), D_MODEL ** -0.5),
        'w_ff_down': nrm(31, (DEPTH, D_FF, D_MODEL), D_FF ** -0.5),
    }


def reference(x_prompt, x_sample, cache_conv, cache_kv_g0, cache_kv_g1, cache_kv_g2, state_s5,
              c_prompt, c_sample, norm_g, final_g, w_ada, b_ada, w_in, conv_w, conv_b, conv_ln_g,
              conv_ln_b, w_o, s5_lam_re, s5_lam_im, s5_log_dt, s5_b_re, s5_b_im, s5_c_re, s5_c_im,
              s5_d, s5_w_glu, s5_b_glu, w_ff_gate, w_ff_up, w_ff_down):
    W = dict(norm_g=norm_g, final_g=final_g, w_ada=w_ada, b_ada=b_ada, w_in=w_in, conv_w=conv_w,
             conv_b=conv_b, conv_ln_g=conv_ln_g, conv_ln_b=conv_ln_b, w_o=w_o,
             s5_lam_re=s5_lam_re, s5_lam_im=s5_lam_im, s5_log_dt=s5_log_dt, s5_b_re=s5_b_re,
             s5_b_im=s5_b_im, s5_c_re=s5_c_re, s5_c_im=s5_c_im, s5_d=s5_d, s5_w_glu=s5_w_glu,
             s5_b_glu=s5_b_glu, w_ff_gate=w_ff_gate, w_ff_up=w_ff_up, w_ff_down=w_ff_down)
    pos_p = jnp.arange(x_prompt.shape[1])
    pos_s = PAST_LEN + jnp.arange(x_sample.shape[1])
    y_prompt, conv_p, kvs_p, s5_p = run_trunk(x_prompt, c_prompt, pos_p, None, None, None, W)
    y_sample, conv_s, kvs_s, s5_s = run_trunk(x_sample, c_sample, pos_s, cache_conv,
                                              [cache_kv_g0, cache_kv_g1, cache_kv_g2], state_s5, W)
    kv0_p, kv1_p, kv2_p = kvs_p
    kv0_s, kv1_s, kv2_s = kvs_s
    return (y_prompt, y_sample, conv_p, kv0_p, kv1_p, kv2_p, s5_p,
            conv_s, kv0_s, kv1_s, kv2_s, s5_s)
```

```cpp
#include <hip/hip_runtime.h>
#include <cstdio>
#include <cstdint>
#define MK_PER_PHASE 0
namespace pg8 {
#define PG8_LAS __attribute__((address_space(3)))
typedef unsigned short bf16_t;
typedef short bf16x8 __attribute__((ext_vector_type(8)));
typedef float f32x4 __attribute__((ext_vector_type(4)));
typedef unsigned u32x4 __attribute__((ext_vector_type(4)));
constexpr int BM = 256, BK = 64, HALF = 128, HTB = HALF * BK * 2  , STAGE_BYTES = 8 * HTB, NXCD = 8, WGM = 8;

__host__ __device__ __forceinline__ int lds_byte(int r, int c) { const int st = (r >> 4) * 2 + (c >> 5), rr = r & 15, cc = c & 31, ob = rr * 64 + cc * 2; return st * 1024 + (ob ^ (((ob >> 9) & 1) << 5)); }
__host__ __device__ __forceinline__ void stage_rc(int b, int& R, int& C) { const int st = b / 1024, sb = b % 1024, swz = sb ^ (((sb >> 9) & 1) << 5); R = (st >> 1) * 16 + swz / 64; C = (st & 1) * 32 + (swz % 64) / 2; }
__host__ __device__ __forceinline__ int perm32(int rho) { const int n = rho >> 4, i = rho & 15; return 8 * (i >> 2) + 4 * n + (i & 3); }

__device__ __forceinline__ int lane_id_v() { int l; asm volatile("v_mbcnt_lo_u32_b32 %0, -1, 0\n\tv_mbcnt_hi_u32_b32 %0, -1, %0" : "=v"(l)); return l; }
struct Unit { int pm, pn, kb, sl; };
struct Gemm { const bf16_t* A; const bf16_t* Bt; int M, N, K, Kl; };

struct StaticOrder {
    int nM, nN, nwg, G, c;
    __host__ __device__ void init(int M, int N, int G_, int c_) { nM = M / BM; nN = N / BM; nwg = nM * nN; G = G_; c = c_; }
    __host__ __device__ bool next(int i, Unit& u) const {
        const long L = (long)i * G + c; if (L >= nwg) return false;
        int wgid = (int)L; { const int q = nwg / NXCD, r = nwg % NXCD, xcd = wgid % NXCD, off = wgid / NXCD; wgid = (xcd < r ? xcd * (q + 1) : r * (q + 1) + (xcd - r) * q) + off; }
        const int nig = WGM * nN, gid = wgid / nig, fm = gid * WGM, gsz = (nM - fm) < WGM ? (nM - fm) : WGM;
        u.pm = fm + ((wgid % nig) % gsz); u.pn = (wgid % nig) / gsz; u.kb = 0; u.sl = 0; return true;
    }
    __device__ __forceinline__ void a_ready(const Unit&) const {}
    __device__ __forceinline__ void done(const Unit&) const {}
};
struct SplitOrder {
    int pm0, npm, nN, nS, G, c, Kl;
    __host__ __device__ void init(int pm0_, int npm_, int N, int nS_, int Kl_, int G_, int c_) { pm0 = pm0_; npm = npm_; nN = N / BM; nS = nS_; Kl = Kl_; G = G_; c = c_; }
    __host__ __device__ bool next(int i, Unit& u) const {
        const int L = i * G + c; if (L >= npm * nN * nS) return false;
        u.sl = L % nS; const int r = L / nS; u.pn = r % nN; u.pm = pm0 + r / nN; u.kb = u.sl * Kl * 2; return true;
    }
    __device__ __forceinline__ void a_ready(const Unit&) const {}
    __device__ __forceinline__ void done(const Unit&) const {}
};


__device__ __forceinline__ unsigned cvt_pk_bf16(float lo, float hi) { unsigned r; asm volatile("v_cvt_pk_bf16_f32 %0, %1, %2" : "=v"(r) : "v"(lo), "v"(hi)); return r; }
typedef float f32x2 __attribute__((ext_vector_type(2)));
__device__ __forceinline__ f32x2 gelu_pk(f32x2 v) {
    const f32x2 av = __builtin_elementwise_abs(v), d = av * 0.2316418882f + 1.0f;
    f32x2 t; t.x = __builtin_amdgcn_rcpf(d.x); t.y = __builtin_amdgcn_rcpf(d.y);
    f32x2 q = t * 0.5307027145f + (-0.7265760135f); q = q * t + 0.7107068705f; q = q * t + (-0.142248368f); q = q * t + 0.127414796f; q = q * t;
    const f32x2 s = (v * v) * (-0.72134752044f);
    f32x2 e; e.x = __builtin_amdgcn_exp2f(s.x); e.y = __builtin_amdgcn_exp2f(s.y);
    const f32x2 m = v * (q * e), r = v - m;
    f32x2 o; o.x = v.x < 0.f ? m.x : r.x; o.y = v.y < 0.f ? m.y : r.y; return o;
}

template <int ACT  > struct EpiBf16 {
    static constexpr bool PERM = true, AFTER_DRAIN = false; static_assert(ACT == 0 || ACT == 1, "EpiBf16: ACT is 0 (none) or 1 (gelu_pk)");
    bf16_t* O; int ldc; const float* bias; int split_cols; size_t split_stride; float scale0;
    __device__ __forceinline__ void operator()(const f32x4 (&acc)[2][2][4][2], const Unit& u, int wr, int wc, int fr, int fq) const {
        const int row0 = u.pm * BM + wr * 64 + fr; int colt = u.pn * BM; bf16_t* base = O;
        float sc = 1.f; if (split_cols) { const int t = colt / split_cols; base += (size_t)t * split_stride; colt -= t * split_cols; if (t == 0) sc = scale0; }
        const int col0 = colt + wc * 32 + 8 * fq, bcol0 = u.pn * BM + wc * 32 + 8 * fq;
        f32x4 bv[2][2];
#pragma unroll
        for (int bj = 0; bj < 2; ++bj)
#pragma unroll
            for (int n = 0; n < 2; ++n) bv[bj][n] = bias ? *(const f32x4*)(bias + bcol0 + bj * HALF + 4 * n) : (f32x4){0.f, 0.f, 0.f, 0.f};
#pragma unroll
        for (int ai = 0; ai < 2; ++ai)
#pragma unroll
            for (int m = 0; m < 4; ++m) { bf16_t* rowp = base + (size_t)(row0 + ai * HALF + m * 16) * ldc + col0;
#pragma unroll
                for (int bj = 0; bj < 2; ++bj) { f32x4 v0 = acc[ai][bj][m][0] + bv[bj][0], v1 = acc[ai][bj][m][1] + bv[bj][1];
                    if (ACT == 1) { f32x2 a = gelu_pk((f32x2){v0[0], v0[1]}), b = gelu_pk((f32x2){v0[2], v0[3]}), c = gelu_pk((f32x2){v1[0], v1[1]}), d = gelu_pk((f32x2){v1[2], v1[3]});
                        v0 = (f32x4){a.x, a.y, b.x, b.y}; v1 = (f32x4){c.x, c.y, d.x, d.y}; }
                    v0 = v0 * sc; v1 = v1 * sc; u32x4 w; w.x = cvt_pk_bf16(v0[0], v0[1]); w.y = cvt_pk_bf16(v0[2], v0[3]); w.z = cvt_pk_bf16(v1[0], v1[1]); w.w = cvt_pk_bf16(v1[2], v1[3]);
                    *(u32x4*)(rowp + bj * HALF) = w; } }
    }
};

template <class Epi, class Sched, bool ALIGN_EPI = false, bool SP2 = false>
__device__ __forceinline__ void gemm_phase(PG8_LAS unsigned char* lds, const Gemm g, const Sched& S, const Epi& E, int wave_in) {
    const int lane = lane_id_v(), wid = wave_in, tid = wid * 64 + lane, wr = wid >> 2, wc = wid & 3, fr = lane & 15, fq = lane >> 4;
    const int K = g.K, nt = g.Kl / BK;
    unsigned voffA[2], voffB[2];
#pragma unroll
    for (int i = 0; i < 2; ++i) { int R, C; stage_rc(tid * 16 + i * 8192, R, C); const int Rb = Epi::PERM ? ((R & ~31) + perm32(R & 31)) : R;
        voffA[i] = (unsigned)(R * K + C) * 2u; voffB[i] = (unsigned)(Rb * K + C) * 2u; }
    const size_t kstep = (size_t)(BK * 2);
    const size_t hstep = (size_t)HALF * K * 2;
    const size_t tstep = 2 * hstep;
    const unsigned ldsw = (unsigned)wid * 1024u;
    const int aoff = lds_byte(wr * 64 + fr, fq * 8), boff = lds_byte(wc * 32 + fr, fq * 8);
#define PG8_SA(b, h) (((b) * 2 + (h)) * HTB)
#define PG8_SB(b, h) ((4 + (b) * 2 + (h)) * HTB)
#define PG8_STAGE(bufoff, gbase, voff) do { _Pragma("unroll") for (int _i = 0; _i < 2; ++_i) \
        __builtin_amdgcn_global_load_lds((const unsigned*)((const char*)(gbase) + (voff)[_i]), (PG8_LAS unsigned*)(lds + (bufoff) + ldsw + _i * 8192), 16, 0, 0); } while (0)
#define PG8_LDA(dst, b, h) do { _Pragma("unroll") for (int m = 0; m < 4; ++m) _Pragma("unroll") for (int k = 0; k < 2; ++k) dst[m][k] = *(const PG8_LAS bf16x8*)(lds + PG8_SA(b, h) + aoff + m * 2048 + k * 1024); } while (0)
#define PG8_LDB(dst, b, h) do { _Pragma("unroll") for (int n = 0; n < 2; ++n) _Pragma("unroll") for (int k = 0; k < 2; ++k) dst[n][k] = *(const PG8_LAS bf16x8*)(lds + PG8_SB(b, h) + boff + n * 2048 + k * 1024); } while (0)
#define PG8_MMA(ai, bj, At, Bt) do { __builtin_amdgcn_s_setprio(1); _Pragma("unroll") for (int m = 0; m < 4; ++m) _Pragma("unroll") for (int n = 0; n < 2; ++n) _Pragma("unroll") for (int k = 0; k < 2; ++k) \
        acc[ai][bj][m][n] = __builtin_amdgcn_mfma_f32_16x16x32_bf16(Bt[n][k], At[m][k], acc[ai][bj][m][n], 0, 0, 0); __builtin_amdgcn_s_setprio(0); } while (0)
#define PG8_WAIT_V(n) asm volatile("s_waitcnt vmcnt(" #n ")" ::: "memory")
#define PG8_WAIT_L(n) asm volatile("s_waitcnt lgkmcnt(" #n ")" ::: "memory")
#define PG8_BAR __builtin_amdgcn_s_barrier()
#define PG8_SCHED __builtin_amdgcn_sched_barrier(0)
    Unit cur, nxt; int ui = 0;
    if (!S.next(0, cur)) return;
    f32x4 acc[2][2][4][2];
#pragma unroll
    for (int a = 0; a < 2; ++a)
#pragma unroll
        for (int b = 0; b < 2; ++b)
#pragma unroll
            for (int m = 0; m < 4; ++m)
#pragma unroll
                for (int n = 0; n < 2; ++n) acc[a][b][m][n] = (f32x4){0.f, 0.f, 0.f, 0.f};
    bf16x8 At[4][2], B0[2][2], B1[2][2];
    const char* cA = (const char*)g.A + (size_t)cur.pm * tstep + cur.kb; const char* cB = (const char*)g.Bt + (size_t)cur.pn * tstep + cur.kb;
    S.a_ready(cur);
    if constexpr (SP2) {
        PG8_STAGE(PG8_SB(0, 0), cB, voffB); PG8_STAGE(PG8_SB(0, 1), cB + hstep, voffB); PG8_STAGE(PG8_SA(0, 0), cA, voffA); PG8_STAGE(PG8_SA(0, 1), cA + hstep, voffA);
        if (wr == 1) PG8_BAR;
        PG8_WAIT_V(2); PG8_BAR;
        PG8_STAGE(PG8_SB(1, 0), cB + kstep, voffB); PG8_STAGE(PG8_SA(1, 0), cA + kstep, voffA); PG8_STAGE(PG8_SB(1, 1), cB + hstep + kstep, voffB);
        PG8_WAIT_V(6); PG8_BAR;
    } else {
        PG8_STAGE(PG8_SB(0, 0), cB, voffB); PG8_STAGE(PG8_SA(0, 0), cA, voffA); PG8_STAGE(PG8_SB(0, 1), cB + hstep, voffB); PG8_STAGE(PG8_SA(0, 1), cA + hstep, voffA);
        if (wr == 1) PG8_BAR;
        PG8_WAIT_V(4); PG8_BAR;
        PG8_STAGE(PG8_SB(1, 0), cB + kstep, voffB); PG8_STAGE(PG8_SA(1, 0), cA + kstep, voffA); PG8_STAGE(PG8_SB(1, 1), cB + hstep + kstep, voffB);
        PG8_WAIT_V(6); PG8_BAR;
    }
    for (;;) {
        const bool has_next = S.next(ui + 1, nxt);
        const char* nA = has_next ? (const char*)g.A + (size_t)nxt.pm * tstep + nxt.kb : cA; const char* nB = has_next ? (const char*)g.Bt + (size_t)nxt.pn * tstep + nxt.kb : cB;
        for (int t = 0; t < nt; t += 2) {
            const bool last = (t == nt - 2);
            const char* a1 = cA + (size_t)(t + 1) * kstep;
            const char* a2 = last ? nA : cA + (size_t)(t + 2) * kstep; const char* b2 = last ? nB : cB + (size_t)(t + 2) * kstep;
            const char* a3 = a2 + kstep; const char* b3 = b2 + kstep;
            if (last && has_next) S.a_ready(nxt);
            if constexpr (SP2) {
            PG8_LDB(B0, 0, 0); PG8_LDB(B1, 0, 1); PG8_SCHED; PG8_LDA(At, 0, 0); PG8_STAGE(PG8_SA(1, 1), a1 + hstep, voffA);
            PG8_WAIT_V(8); PG8_WAIT_L(0); PG8_BAR; PG8_MMA(0, 0, At, B0); PG8_MMA(0, 1, At, B1); PG8_BAR; PG8_SCHED;
            PG8_LDA(At, 0, 1); PG8_STAGE(PG8_SB(0, 0), b2, voffB); PG8_STAGE(PG8_SB(0, 1), b2 + hstep, voffB); PG8_STAGE(PG8_SA(0, 0), a2, voffA);
            PG8_WAIT_V(8); PG8_WAIT_L(0); PG8_BAR; PG8_MMA(1, 0, At, B0); PG8_MMA(1, 1, At, B1); PG8_BAR; PG8_SCHED;
            PG8_LDB(B0, 1, 0); PG8_LDB(B1, 1, 1); PG8_SCHED; PG8_LDA(At, 1, 0); PG8_STAGE(PG8_SA(0, 1), a2 + hstep, voffA);
            PG8_WAIT_V(8); PG8_WAIT_L(0); PG8_BAR; PG8_MMA(0, 0, At, B0); PG8_MMA(0, 1, At, B1); PG8_BAR; PG8_SCHED;
            PG8_LDA(At, 1, 1); PG8_STAGE(PG8_SB(1, 0), b3, voffB); PG8_STAGE(PG8_SB(1, 1), b3 + hstep, voffB); PG8_STAGE(PG8_SA(1, 0), a3, voffA);
            PG8_WAIT_V(8); PG8_WAIT_L(0); PG8_BAR; PG8_MMA(1, 0, At, B0); PG8_MMA(1, 1, At, B1); PG8_BAR; PG8_SCHED;
            } else {
            PG8_LDB(B0, 0, 0); PG8_SCHED; PG8_LDA(At, 0, 0); PG8_STAGE(PG8_SA(1, 1), a1 + hstep, voffA);
            PG8_WAIT_L(8); PG8_BAR; PG8_WAIT_L(0); PG8_MMA(0, 0, At, B0); PG8_BAR; PG8_SCHED;
            PG8_LDB(B1, 0, 1); PG8_STAGE(PG8_SB(0, 0), b2, voffB);
            PG8_BAR; PG8_WAIT_L(0); PG8_MMA(0, 1, At, B1); PG8_BAR;
            PG8_LDA(At, 0, 1); PG8_STAGE(PG8_SA(0, 0), a2, voffA);
            PG8_BAR; PG8_WAIT_L(0); PG8_MMA(1, 0, At, B0); PG8_BAR; PG8_SCHED;
            PG8_STAGE(PG8_SB(0, 1), b2 + hstep, voffB);
            PG8_WAIT_V(6); PG8_BAR; PG8_MMA(1, 1, At, B1); PG8_BAR;
            PG8_LDB(B0, 1, 0); PG8_SCHED; PG8_LDA(At, 1, 0); PG8_STAGE(PG8_SA(0, 1), a2 + hstep, voffA);
            PG8_WAIT_L(8); PG8_BAR; PG8_WAIT_L(0); PG8_MMA(0, 0, At, B0); PG8_BAR; PG8_SCHED;
            PG8_LDB(B1, 1, 1); PG8_STAGE(PG8_SB(1, 0), b3, voffB);
            PG8_BAR; PG8_WAIT_L(0); PG8_MMA(0, 1, At, B1); PG8_BAR;
            PG8_LDA(At, 1, 1); PG8_STAGE(PG8_SA(1, 0), a3, voffA);
            PG8_BAR; PG8_WAIT_L(0); PG8_MMA(1, 0, At, B0); PG8_BAR; PG8_SCHED;
            PG8_STAGE(PG8_SB(1, 1), b3 + hstep, voffB);
            PG8_WAIT_V(6); PG8_BAR; PG8_MMA(1, 1, At, B1); PG8_BAR;
            }
        }
        if constexpr (ALIGN_EPI) { if (wr == 0) PG8_BAR; }
        if constexpr (!Epi::AFTER_DRAIN) { E(acc, cur, wr, wc, fr, fq); S.done(cur); }
        if (!has_next) break;
#pragma unroll
        for (int a = 0; a < 2; ++a)
#pragma unroll
            for (int b = 0; b < 2; ++b)
#pragma unroll
                for (int m = 0; m < 4; ++m)
#pragma unroll
                    for (int n = 0; n < 2; ++n) acc[a][b][m][n] = (f32x4){0.f, 0.f, 0.f, 0.f};
        cur = nxt; cA = nA; cB = nB; ++ui;
        if constexpr (ALIGN_EPI) { if (wr == 1) PG8_BAR; }
    }
    PG8_WAIT_V(0);
    if constexpr (!ALIGN_EPI) { if (wr == 0) PG8_BAR; }
    PG8_BAR;
    if constexpr (Epi::AFTER_DRAIN) { E.fused(acc, cur, wr, wc, fr, fq, lds, wid, lane); S.done(cur); }
#undef PG8_SA
#undef PG8_SB
#undef PG8_STAGE
#undef PG8_LDA
#undef PG8_LDB
#undef PG8_MMA
#undef PG8_WAIT_V
#undef PG8_WAIT_L
#undef PG8_BAR
#undef PG8_SCHED
}
}

constexpr int D = 1024, MP = 16384, MS = 1024, M = MP + MS, SEQ = 4096, NB_P = 4, NB_S = 128, TS = 8, NBT = NB_P + NB_S;
constexpr int FF = 2816, INC = 3328, MIXK = 768, ATW = 768, CCH = 512, MODLD = 4 * 6144;
constexpr float EPS = 1e-6f;
constexpr float QSCALE = 0.125f * 1.4426950408889634f;
constexpr size_t O_YP = 0, O_YS = O_YP + (size_t)MP * D, O_CONVP = O_YS + (size_t)MS * D, O_KV0P = O_CONVP + 2ull * 4 * 30 * 512,
    O_KV1P = O_KV0P + 2ull * 4 * 128 * 512, O_KV2P = O_KV1P + 2ull * 4 * 512 * 512, O_S5P = O_KV2P + 2ull * 4 * 2048 * 512,
    O_CONVS = O_S5P + 2ull * 4 * 64 * 64 * 2, O_KV0S = O_CONVS + 2ull * 128 * 30 * 512, O_KV1S = O_KV0S + 2ull * 128 * 8 * 512,
    O_KV2S = O_KV1S + 2ull * 128 * 8 * 512, O_S5S = O_KV2S + 2ull * 128 * 8 * 512, O_END = O_S5S + 2ull * 128 * 64 * 64 * 2;
static_assert(O_END == 38199296ull, "output size");

constexpr size_t MiB = 1u << 20;
constexpr size_t WS_CTL = 0, CTL_ZERO_BYTES = 64 * 1024;
constexpr size_t WS_WIN = 1 * MiB;
constexpr size_t WS_WO = WS_WIN + 14 * MiB;
constexpr size_t WS_WGLU = WS_WO + 3 * MiB;
constexpr size_t WS_WGU = WS_WGLU + 8 * MiB;
constexpr size_t WS_WD = WS_WGU + 44 * MiB;
constexpr size_t WS_WADA = WS_WD + 22 * MiB;
constexpr size_t WS_SILC = WS_WADA + 48 * MiB;
constexpr size_t WS_MOD = WS_SILC + 1 * MiB;
constexpr size_t WS_ROPE = WS_MOD + 13 * MiB;
constexpr size_t WS_S5AB = WS_ROPE + 1 * MiB;
constexpr size_t WS_S5ABT = WS_S5AB + 64 * 1024;
constexpr size_t WS_S5BB = WS_S5ABT + 64 * 1024;
constexpr size_t WS_X = WS_S5BB + 1 * MiB;
constexpr size_t WS_XN = WS_X + 68 * MiB;
constexpr size_t WS_Q = WS_XN + 34 * MiB;
constexpr size_t WS_K = WS_Q + 26 * MiB;
constexpr size_t WS_V = WS_K + 26 * MiB;
constexpr size_t WS_U = WS_V + 26 * MiB;
constexpr size_t WS_MIX = WS_U + 17 * MiB;
constexpr size_t WS_OG = WS_MIX + 26 * MiB;
constexpr size_t WS_LSE = WS_OG + 51 * MiB;
constexpr size_t WS_ACT = WS_LSE + 1 * MiB;
constexpr size_t WS_ZZ = WS_ACT + 94 * MiB;
constexpr size_t WS_S5E = WS_ZZ + 34 * MiB;
constexpr size_t WS_S5SIN = WS_S5E + 4 * MiB;
constexpr size_t WS_END = WS_S5SIN + 4 * MiB;
static_assert((size_t)M * D * 4 <= 68 * MiB && (size_t)M * 768 * 2 <= 26 * MiB && (size_t)M * FF * 2 <= 94 * MiB && 3ull * M * 256 * 4 <= 51 * MiB && 132ull * MODLD * 4 <= 13 * MiB, "ws map");

static_assert(WS_K - WS_Q == WS_V - WS_K && O_KV1P == O_KV0P + 4096ull * 128 && O_KV2P == O_KV0P + 4096ull * 640 && O_KV2S - O_KV1S == O_KV1S - O_KV0S, "arithmetic buffer selection");
constexpr int CW_TMO = 0, CW_BAR = 4096;
constexpr int NWAVES = 8;
constexpr int RING_OFF = 0, RING_BYTES = 131072;
constexpr int LDSCTL_OFF = RING_BYTES, MISC_OFF = LDSCTL_OFF + 320;
constexpr int LDS_BYTES = 147456;

#define GAS __attribute__((address_space(1)))
#define LAS __attribute__((address_space(3)))
typedef unsigned short bf16;
typedef unsigned v4u __attribute__((ext_vector_type(4)));
typedef unsigned v2u __attribute__((ext_vector_type(2)));
typedef float f32x4 __attribute__((ext_vector_type(4)));
typedef float f32x2 __attribute__((ext_vector_type(2)));
typedef GAS unsigned gu32;
#define RLX_AGENT __ATOMIC_RELAXED, __HIP_MEMORY_SCOPE_AGENT
#define LDS_WAIT() asm volatile("s_waitcnt lgkmcnt(0)" ::: "memory")
#define VM_WAIT() asm volatile("s_waitcnt vmcnt(0)" ::: "memory")
#define DI __device__ __forceinline__
DI unsigned f2bf(float f) { unsigned u = __builtin_bit_cast(unsigned, f); return (u + 0x7fffu + ((u >> 16) & 1u)) >> 16; }
DI unsigned pk2(float lo, float hi) { return f2bf(lo) | (f2bf(hi) << 16); }
DI float bf2f(unsigned h) { return __builtin_bit_cast(float, h << 16); }
DI float bflo(unsigned w) { return __builtin_bit_cast(float, w << 16); }
DI float bfhi(unsigned w) { return __builtin_bit_cast(float, w & 0xffff0000u); }
DI float fast_exp2(float x) { return __builtin_amdgcn_exp2f(x); }
DI float fast_exp(float x) { return __builtin_amdgcn_exp2f(x * 1.4426950408889634f); }
DI float fast_log2(float x) { return __builtin_amdgcn_logf(x); }
DI float fast_rcp(float x) { return __builtin_amdgcn_rcpf(x); }
DI float sigmoidf_(float x) { return fast_rcp(1.f + fast_exp(-x)); }
DI float gelu_tanh(float x) { const float z = 0.7978845608028654f * (x + 0.044715f * x * x * x); const float e = fast_exp(2.f * z); const float th = 1.f - 2.f * fast_rcp(e + 1.f); return 0.5f * x * (1.f + th); }
template <class T> DI T* uni_ptr(T* p) { const unsigned long long v = (unsigned long long)p; const unsigned lo = __builtin_amdgcn_readfirstlane((unsigned)v), hi = __builtin_amdgcn_readfirstlane((unsigned)(v >> 32)); return (T*)(GAS T*)(((unsigned long long)hi << 32) | lo); }
template <class T> DI T* opaque_uniform(T* p) { const unsigned long long v = (unsigned long long)p; unsigned lo = __builtin_amdgcn_readfirstlane((unsigned)v), hi = __builtin_amdgcn_readfirstlane((unsigned)(v >> 32)); asm volatile("" : "+s"(lo), "+s"(hi)); return (T*)(GAS T*)(((unsigned long long)hi << 32) | lo); }
constexpr size_t LSE_P = (size_t)3 * NB_P * 4 * SEQ;
DI size_t lse_idx_p(int g, int n, int h, int t) { const int sh = 2 * g, r = t & ((1 << sh) - 1), i = t >> sh; return ((size_t)((g * NB_P + n) * 4 + h) << 12) + ((size_t)r << (12 - sh)) + i; }
DI size_t lse_idx_s(int g, int srow, int h) { return LSE_P + ((size_t)g * MS + srow) * 4 + h; }
DI int row_batch(int r) { return r < MP ? (r >> 12) : NB_P + ((r - MP) >> 3); }
template <int K> DI float shx(float v) { return __builtin_bit_cast(float, __builtin_amdgcn_ds_swizzle(__builtin_bit_cast(int, v), (K << 10) | 0x1F)); }
DI void swap32(float v, float& a, float& b) { a = v; b = v; asm volatile("s_nop 1\n\tv_permlane32_swap_b32 %0, %1" : "+v"(a), "+v"(b)); }
DI float sum32(float v) { float a, b; swap32(v, a, b); return a + b; }
DI float max32(float v) { float a, b; swap32(v, a, b); return fmaxf(a, b); }
DI void st8_wt(void* p, unsigned lo, unsigned hi) { __hip_atomic_store((unsigned long long*)p, ((unsigned long long)hi << 32) | lo, __ATOMIC_RELAXED, __HIP_MEMORY_SCOPE_AGENT); }
DI float wave_sum(float v) { v += shx<1>(v); v += shx<2>(v); v += shx<4>(v); v += shx<8>(v); v += shx<16>(v); return sum32(v); }
#define XB_TMO      128
#define XB_XCNT(j)  (256  + 64 * (j))
#define XB_XSUB(j)  (1280 + 64 * (j))
#define XB_XGEN(j)  (2304 + 64 * (j))
#define XB_TOP      3328
#define XB_TOPGEN   3392
#define XCD_BAR_WORDS 3456
#define XB_SPIN_CAP (1u << 18)

__device__ __forceinline__ unsigned xb_ld(unsigned* p)              { return __hip_atomic_load(p, __ATOMIC_RELAXED, __HIP_MEMORY_SCOPE_AGENT); }
__device__ __forceinline__ unsigned xb_add(unsigned* p, unsigned v) { return __hip_atomic_fetch_add(p, v, __ATOMIC_RELAXED, __HIP_MEMORY_SCOPE_AGENT); }
__device__ __forceinline__ unsigned xb_xcc_id() { return (unsigned)__builtin_amdgcn_s_getreg((3 << 11) | 20) & 0xFu; }
#define XB_SPIN(cond, bar) do { unsigned _sp = 0; while (cond) { __builtin_amdgcn_s_sleep(1); \
    if ((++_sp & 255u) == 0u) { if (xb_ld(&(bar)[XB_TMO])) break; if (_sp > XB_SPIN_CAP) { atomicAdd(&(bar)[XB_TMO], 1u); break; } } } } while (0)

struct XcdBarrier {
    unsigned* bar; unsigned x;
    volatile LAS unsigned* st;
};

__device__ __forceinline__ XcdBarrier xcd_barrier_post(unsigned* bar, volatile LAS unsigned* st) {
    XcdBarrier b; b.bar = bar; b.x = xb_xcc_id(); b.st = st;
    if (threadIdx.x == 0) (void)xb_add(&bar[XB_XCNT(b.x)], 1u);
    return b;
}
__device__ __forceinline__ void xcd_barrier_complete(unsigned* bar, unsigned x, unsigned& nloc, unsigned& nx) {
    const unsigned G = gridDim.x * gridDim.y * gridDim.z;
    unsigned sum, cnt, mine, sp = 0u;
    for (;;) {
        sum = 0u; cnt = 0u; mine = 0u;
#pragma unroll
        for (unsigned j = 0; j < 16; ++j) { const unsigned c = xb_ld(&bar[XB_XCNT(j)]); sum += c; cnt += (c > 0u) ? 1u : 0u; mine = (j == x) ? c : mine; }
        if (sum == G) break;
        __builtin_amdgcn_s_sleep(1);
        if ((++sp & 255u) == 0u) { if (xb_ld(&bar[XB_TMO])) break; if (sp > XB_SPIN_CAP) { atomicAdd(&bar[XB_TMO], 1u); break; } }
    }
    nloc = mine > 0u ? mine : 1u; nx = cnt > 0u ? cnt : 1u;
}

__device__ __forceinline__ void xcd_barrier(const XcdBarrier& b, bool settle = false, bool wb = true) {
    asm volatile("s_waitcnt vmcnt(0)" ::: "memory");
    __syncthreads();
    if (threadIdx.x == 0) {
        unsigned* bar = b.bar;
        __builtin_amdgcn_s_waitcnt(0);
        unsigned nloc = b.st[0], nx = b.st[1];
        if (nloc == 0u) { xcd_barrier_complete(bar, b.x, nloc, nx); b.st[0] = nloc; b.st[1] = nx; }
        const unsigned old = xb_add(&bar[XB_XSUB(b.x)], 1u);
        const unsigned gen = old / nloc;
        if (old + 1u == (gen + 1u) * nloc) {
            if (wb) {
            __builtin_amdgcn_fence(__ATOMIC_RELEASE, "agent");
            asm volatile("s_waitcnt vmcnt(0)" ::: "memory");
            }
            asm volatile("buffer_inv sc1" ::: "memory");
            const unsigned og = xb_add(&bar[XB_TOP], 1u);
            const unsigned tg = og / nx;
            if (og + 1u == (tg + 1u) * nx) xb_add(&bar[XB_TOPGEN], 1u);
            else XB_SPIN(xb_ld(&bar[XB_TOPGEN]) == tg, bar);
            if (settle) __builtin_amdgcn_s_sleep(64);
            xb_add(&bar[XB_XGEN(b.x)], 1u);
            asm volatile("s_waitcnt vmcnt(0)" ::: "memory");
        } else {
            asm volatile("buffer_inv sc1" ::: "memory");
            XB_SPIN(xb_ld(&bar[XB_XGEN(b.x)]) == gen, bar);
            if (settle) __builtin_amdgcn_s_sleep(64);
            asm volatile("s_waitcnt vmcnt(0)" ::: "memory");
        }
        __builtin_amdgcn_fence(__ATOMIC_ACQUIRE, "workgroup");
    }
    __syncthreads();
}

#ifndef PROBE_SITE
#define PROBE_SITE 0
#endif
using pg8::Unit;
#ifndef WT_STORES
#define WT_STORES 0
#endif
DI void st16_wt(void* p, v4u v) {
#if WT_STORES
    asm volatile("global_store_dwordx4 %0, %1, off sc1\n\ts_nop 1" :: "v"(p), "v"(v) : "memory");
#else
    *(v4u*)p = v;
#endif
}
DI v4u pack8(const f32x4 a, const f32x4 b) { v4u w; w.x = pg8::cvt_pk_bf16(a[0], a[1]); w.y = pg8::cvt_pk_bf16(a[2], a[3]); w.z = pg8::cvt_pk_bf16(b[0], b[1]); w.w = pg8::cvt_pk_bf16(b[2], b[3]); return w; }

struct EpiMod {
    static constexpr bool PERM = false, AFTER_DRAIN = false;
    float* mod; const float* bias;
    DI void operator()(const f32x4 (&acc)[2][2][4][2], const Unit& u, int wr, int wc, int fr_, int fq_) const {
        const int ln_ = pg8::lane_id_v(), fr = ln_ & 15, fq = ln_ >> 4; (void)fr_; (void)fq_;
        const int col0 = u.pn * 256 + wc * 32 + 4 * fq;
#pragma unroll
        for (int ai = 0; ai < 2; ++ai)
#pragma unroll
            for (int m = 0; m < 4; ++m) { const int r = ai * 128 + wr * 64 + m * 16 + fr;
                if (r < NBT) {
#pragma unroll
                    for (int bj = 0; bj < 2; ++bj)
#pragma unroll
                        for (int n = 0; n < 2; ++n) { const int c = col0 + bj * 128 + n * 16; const f32x4 b = *(const f32x4*)(bias + c); *(f32x4*)(mod + (size_t)r * MODLD + c) = acc[ai][bj][m][n] + b; }
                } }
    }
};

DI void ldx8(const void* base, int is_f32, size_t elem, f32x4& a, f32x4& b) {
    if (is_f32) { const float* p = (const float*)base + elem; a = *(const f32x4*)p; b = *(const f32x4*)(p + 4); }
    else { const v4u w = *(const v4u*)((const bf16*)base + elem); a = (f32x4){bflo(w.x), bfhi(w.x), bflo(w.y), bfhi(w.y)}; b = (f32x4){bflo(w.z), bfhi(w.z), bflo(w.w), bfhi(w.w)}; }
}
struct EpiResid {
    static constexpr bool PERM = true, AFTER_DRAIN = false;
    const void* bp; const void* bs; int bf32; bf16* xo; const float* gate;
    DI void operator()(const f32x4 (&acc)[2][2][4][2], const Unit& u, int wr, int wc, int fr_, int fq_) const {
        const int ln_ = pg8::lane_id_v(), fr = ln_ & 15, fq = ln_ >> 4; (void)fr_; (void)fq_;
        const int col0 = u.pn * 256 + wc * 32 + 8 * fq;
#pragma unroll
        for (int ai = 0; ai < 2; ++ai)
#pragma unroll
            for (int m = 0; m < 4; ++m) { const int r = u.pm * 256 + ai * 128 + wr * 64 + m * 16 + fr; const int nb = row_batch(r);
                const void* src = r < MP ? bp : bs; const size_t roff = (size_t)(r < MP ? r : r - MP) * D; const float* gp = gate + (size_t)nb * MODLD; bf16* dst = xo + (size_t)r * D;
#pragma unroll
                for (int bj = 0; bj < 2; ++bj) { const int c = col0 + bj * 128;
                    const f32x4 g0 = *(const f32x4*)(gp + c), g1 = *(const f32x4*)(gp + c + 4); f32x4 x0, x1; ldx8(src, bf32, roff + c, x0, x1);
                    *(v4u*)(dst + c) = pack8(x0 + g0 * acc[ai][bj][m][0], x1 + g1 * acc[ai][bj][m][1]); }
                asm volatile("" ::: "memory"); }
    }
};

struct EpiPartial {
    static constexpr bool PERM = true, AFTER_DRAIN = false;
    float* part; int ld;
    DI void operator()(const f32x4 (&acc)[2][2][4][2], const Unit& u, int wr, int wc, int fr_, int fq_) const {
        const int ln_ = pg8::lane_id_v(), fr = ln_ & 15, fq = ln_ >> 4; (void)fr_; (void)fq_;
        const int col0 = u.pn * 256 + wc * 32 + 8 * fq; float* pb = part + (size_t)u.sl * MS * ld;
#pragma unroll
        for (int ai = 0; ai < 2; ++ai)
#pragma unroll
            for (int m = 0; m < 4; ++m) { const int r = u.pm * 256 + ai * 128 + wr * 64 + m * 16 + fr - MP; float* dst = pb + (size_t)r * ld + col0;
#pragma unroll
                for (int bj = 0; bj < 2; ++bj) { *(f32x4*)(dst + bj * 128) = acc[ai][bj][m][0]; *(f32x4*)(dst + bj * 128 + 4) = acc[ai][bj][m][1]; } }
    }
};

struct EpiSwiGLU {
    static constexpr bool PERM = true, AFTER_DRAIN = false;
    bf16* act;
    DI void operator()(const f32x4 (&acc)[2][2][4][2], const Unit& u, int wr, int wc, int fr_, int fq_) const {
        const int ln_ = pg8::lane_id_v(), fr = ln_ & 15, fq = ln_ >> 4; (void)fr_; (void)fq_;
        const int col0 = u.pn * 128 + wc * 32 + 8 * fq;
#pragma unroll
        for (int ai = 0; ai < 2; ++ai)
#pragma unroll
            for (int m = 0; m < 4; ++m) { const int r = u.pm * 256 + ai * 128 + wr * 64 + m * 16 + fr; f32x4 o[2];
#pragma unroll
                for (int n = 0; n < 2; ++n) { const f32x4 g = acc[ai][0][m][n], up = acc[ai][1][m][n];
#pragma unroll
                    for (int e = 0; e < 4; ++e) { float sg = sigmoidf_(g[e]); if (PROBE_SITE == 15) { float ge = g[e]; asm volatile("" : "+v"(ge)); sg = 0.5f * (sg + sigmoidf_(ge)); } o[n][e] = g[e] * up[e] * sg; } }
                st16_wt(act + (size_t)r * FF + col0, pack8(o[0], o[1])); }
    }
};

struct EpiGLU {
    static constexpr bool PERM = true, AFTER_DRAIN = false;
    bf16* x; const float* gate; const float* bglu;
    DI void operator()(const f32x4 (&acc)[2][2][4][2], const Unit& u, int wr, int wc, int fr_, int fq_) const {
        const int ln_ = pg8::lane_id_v(), fr = ln_ & 15, fq = ln_ >> 4; (void)fr_; (void)fq_;
        const int col0 = u.pn * 128 + wc * 32 + 8 * fq;
        f32x4 ba[2], bb[2];
#pragma unroll
        for (int n = 0; n < 2; ++n) { ba[n] = *(const f32x4*)(bglu + col0 + 4 * n); bb[n] = *(const f32x4*)(bglu + D + col0 + 4 * n); }
#pragma unroll
        for (int ai = 0; ai < 2; ++ai)
#pragma unroll
            for (int m = 0; m < 4; ++m) { const int r = u.pm * 256 + ai * 128 + wr * 64 + m * 16 + fr; const int nb = row_batch(r);
                bf16* xr = x + (size_t)r * D + col0; const float* gp = gate + (size_t)nb * MODLD + col0;
                f32x4 xv[2]; ldx8(xr, 0, 0, xv[0], xv[1]);
#pragma unroll
                for (int n = 0; n < 2; ++n) { const f32x4 a = acc[ai][0][m][n] + ba[n], b = acc[ai][1][m][n] + bb[n]; const f32x4 g = *(const f32x4*)(gp + 4 * n);
#pragma unroll
                    for (int e = 0; e < 4; ++e) xv[n][e] += g[e] * a[e] * sigmoidf_(b[e]); }
                *(v4u*)xr = pack8(xv[0], xv[1]);
                asm volatile("" ::: "memory"); }
    }
};

struct EpiIn {
    static constexpr bool PERM = true, AFTER_DRAIN = false;
    bf16 *U, *Q; const float* rope; float* out; int ei;
    DI void operator()(const f32x4 (&acc)[2][2][4][2], const Unit& u, int wr, int wc, int fr_, int fq_) const {
        const int ln_ = pg8::lane_id_v(), fr = ln_ & 15, fq = ln_ >> 4; (void)fr_; (void)fq_;
        const int pn = u.pn;
        if (pn < 4) {
            const int col0 = pn * 128 + wc * 32 + 8 * fq;
#pragma unroll
            for (int ai = 0; ai < 2; ++ai)
#pragma unroll
                for (int m = 0; m < 4; ++m) { const int r = u.pm * 256 + ai * 128 + wr * 64 + m * 16 + fr; f32x4 o[2];
#pragma unroll
                    for (int n = 0; n < 2; ++n) { const f32x4 v = acc[ai][0][m][n], g = acc[ai][1][m][n];
#pragma unroll
                        for (int e = 0; e < 4; ++e) o[n][e] = v[e] * sigmoidf_(g[e]); }
                    *(v4u*)(U + (size_t)r * CCH + col0) = pack8(o[0], o[1]);
                    float* cp = nullptr;
                    if (r < MP) { const int t = r & (SEQ - 1); if (t >= SEQ - 30) cp = out + O_CONVP + ((size_t)(ei * NB_P + (r >> 12)) * 30 + (t - (SEQ - 30))) * CCH; }
                    else { const int n = (r - MP) >> 3, t = r & 7; cp = out + O_CONVS + ((size_t)(ei * NB_S + n) * 30 + 22 + t) * CCH; }
                    if (cp) { __builtin_nontemporal_store(o[0], (f32x4*)(cp + col0)); __builtin_nontemporal_store(o[1], (f32x4*)(cp + col0 + 4)); } }
            return;
        }
        const int kind = (pn - 4) / 3, g = (pn - 4) % 3;
        const bool do_rope = (kind < 2) && ((wc & 1) == 0);
        bf16* dstb = Q + (size_t)kind * ((WS_K - WS_Q) / 2);
        const int keep = 128 << (2 * g);
        const size_t okvp = O_KV0P + (size_t)4096 * 128 * (((1 << (2 * g)) - 1) / 3), okvs = O_KV0S + (size_t)g * (O_KV1S - O_KV0S);
#pragma unroll
        for (int ai = 0; ai < 2; ++ai)
#pragma unroll
            for (int m = 0; m < 4; ++m) { const int r = u.pm * 256 + ai * 128 + wr * 64 + m * 16 + fr;
                const int pos = r < MP ? (r & (SEQ - 1)) : 2048 + (r & 7);
                f32x4 cs0 = {1.f, 1.f, 1.f, 1.f}, cs1 = cs0, sn0 = {0.f, 0.f, 0.f, 0.f}, sn1 = sn0;
                if (do_rope) { const float* rp = rope + (size_t)pos * 16; cs0 = *(const f32x4*)(rp); cs1 = *(const f32x4*)(rp + 4); sn0 = *(const f32x4*)(rp + 8); sn1 = *(const f32x4*)(rp + 12);
                    if (fq == 0) { sn0 = -sn0; sn1 = -sn1; } }
                float* kvp = nullptr;
                if (kind > 0) {
                    if (r < MP) { const int t = r & (SEQ - 1); if (t >= SEQ - keep) kvp = out + okvp + (((size_t)(ei * NB_P + (r >> 12)) * keep + (t - (SEQ - keep))) * 2 + (kind - 1)) * 256; }
                    else { const int n = (r - MP) >> 3, t = r & 7; kvp = out + okvs + (((size_t)(ei * NB_S + n) * 8 + t) * 2 + (kind - 1)) * 256; }
                }
#pragma unroll
                for (int bj = 0; bj < 2; ++bj) { f32x4 v0 = acc[ai][bj][m][0], v1 = acc[ai][bj][m][1];
                    if (do_rope) {
                        f32x4 p0, p1;
#pragma unroll
                        for (int e = 0; e < 4; ++e) { p0[e] = shx<16>(v0[e]); p1[e] = shx<16>(v1[e]); }
                        if (fq < 2) { v0 = v0 * cs0 + p0 * sn0; v1 = v1 * cs1 + p1 * sn1; }
                    }
                    if (kind == 0) { v0 = v0 * QSCALE; v1 = v1 * QSCALE; }
                    const int cc = bj * 128 + wc * 32 + 8 * fq;
                    *(v4u*)(dstb + (size_t)r * ATW + g * 256 + cc) = pack8(v0, v1);
                    if (kvp) { __builtin_nontemporal_store(v0, (f32x4*)(kvp + cc)); __builtin_nontemporal_store(v1, (f32x4*)(kvp + cc + 4)); } }
                asm volatile("" ::: "memory"); }
    }
};

struct Frame {
    LAS unsigned char* lds;
    volatile LAS unsigned* MISC;
    gu32* ctl;
    int wave, G, NGW;
    int lane, tid, gw;
    unsigned char* ws; float* out;
};

#define PH_IDS(F) do { (F).lane = pg8::lane_id_v(); (F).ws = opaque_uniform((F).ws); (F).out = opaque_uniform((F).out); { int wv_ = __builtin_amdgcn_readfirstlane((F).wave); asm volatile("" : "+s"(wv_)); (F).wave = wv_; } (F).tid = (F).wave * 64 + (F).lane; (F).gw = (int)blockIdx.x * NWAVES + (F).wave; } while (0)
DI double exp_small(double x) {
    const double y = x * (1.0 / 1024.0);
    double r = 1.0 / 362880.0;
    r = r * y + 1.0 / 40320.0; r = r * y + 1.0 / 5040.0; r = r * y + 1.0 / 720.0; r = r * y + 1.0 / 120.0; r = r * y + 1.0 / 24.0; r = r * y + 1.0 / 6.0; r = r * y + 0.5; r = r * y + 1.0; r = r * y + 1.0;
#pragma unroll
    for (int i = 0; i < 10; ++i) r = r * r;
    return r;
}
DI void sincos_d(double x, double& s, double& c) {
    const double TWO_PI_HI = 6.283185307179586232, TWO_PI_LO = 2.4492935982947064e-16;
    const double k = __builtin_rint(x * 0.15915494309189535);
    double r = __builtin_fma(-k, TWO_PI_HI, x); r = __builtin_fma(-k, TWO_PI_LO, r);
    const double y = r * 0.25, y2 = y * y;
    double sp = -1.0 / 1307674368000.0;
    sp = sp * y2 + 1.0 / 6227020800.0; sp = sp * y2 - 1.0 / 39916800.0; sp = sp * y2 + 1.0 / 362880.0; sp = sp * y2 - 1.0 / 5040.0; sp = sp * y2 + 1.0 / 120.0; sp = sp * y2 - 1.0 / 6.0; sp = sp * y2 + 1.0;
    double s1 = sp * y;
    double cp = 1.0 / 20922789888000.0;
    cp = cp * y2 - 1.0 / 87178291200.0; cp = cp * y2 + 1.0 / 479001600.0; cp = cp * y2 - 1.0 / 3628800.0; cp = cp * y2 + 1.0 / 40320.0; cp = cp * y2 - 1.0 / 720.0; cp = cp * y2 + 1.0 / 24.0; cp = cp * y2 - 0.5; cp = cp * y2 + 1.0;
    double c1 = cp;
#pragma unroll
    for (int i = 0; i < 2; ++i) { const double s2 = 2.0 * s1 * c1, c2 = c1 * c1 - s1 * s1; s1 = s2; c1 = c2; }
    s = s1; c = c1;
}

#ifndef PROLOGUE_BATCHED
#define PROLOGUE_BATCHED 1
#endif
DI int map_row(int mode, int n) {
    if (mode == 1) { if (n < 512) return 256 * (n >> 7) + (n & 127); if (n < 1024) { const int q = n - 512; return 256 * (q >> 7) + 128 + (q & 127); } return n; }
    if (mode == 2) return 256 * (n >> 7) + (n & 127);
    if (mode == 3) return 256 * (n >> 7) + 128 + (n & 127);
    if (mode == 4) { if (n < 1024) return 256 * (n >> 7) + (n & 127); const int q = n - 1024; return 256 * (q >> 7) + 128 + (q & 127); }
    return n;
}
DI void p0_transpose_item(const float* W, int K, int N, bf16* WT, int mode, int row_off, LAS float* scr, int item, int lane) {
    const int nblk = N / 32, kb = item / nblk, nb = item % nblk, k0 = 64 * kb, n0 = 32 * nb;
#if PROLOGUE_BATCHED
    float wv[32];
#pragma unroll
    for (int i = 0; i < 32; ++i) { const int kk = 2 * i + (lane >> 5); wv[i] = __builtin_nontemporal_load(W + (size_t)(k0 + kk) * N + n0 + (lane & 31)); }
#pragma unroll
    for (int i = 0; i < 32; ++i) { const int kk = 2 * i + (lane >> 5); scr[kk * 33 + (lane & 31)] = wv[i]; }
#else
#pragma unroll 8
    for (int i = 0; i < 32; ++i) { const int kk = 2 * i + (lane >> 5); scr[kk * 33 + (lane & 31)] = W[(size_t)(k0 + kk) * N + n0 + (lane & 31)]; }
#endif
    LDS_WAIT(); asm volatile("" ::: "memory");
    const int c = lane & 7; const int r0 = map_row(mode, n0) + row_off;
#pragma unroll
    for (int j = 0; j < 4; ++j) { const int n = (lane >> 3) + 8 * j; const LAS float* s = scr + (8 * c) * 33 + n;
        v4u o; o.x = pk2(s[0 * 33], s[1 * 33]); o.y = pk2(s[2 * 33], s[3 * 33]); o.z = pk2(s[4 * 33], s[5 * 33]); o.w = pk2(s[6 * 33], s[7 * 33]);
        *(GAS v4u*)(WT + (size_t)(r0 + n) * K + k0 + 8 * c) = o; }
    LDS_WAIT(); asm volatile("" ::: "memory");
}

struct Ins { const float* p[32]; };

constexpr int P0_NITEMS = 2 * 16 * 104 + 2 * 12 * 32 + 2 * 16 * 64 + 8 * 16 * 88 + 4 * 44 * 32 + 4 * 16 * 192, P0_ADA_ITEMS = 4 * 16 * 192, P0_DEFER = 0;
DI void p0_items(Frame& F, const Ins& I, int lo, int hi, int wi, int nw) {
    LAS float* scr = (LAS float*)(F.lds + RING_OFF + F.wave * 16384);
    unsigned char* ws = F.ws;
    constexpr int I_IN = 16 * 104, I_O = 12 * 32, I_GLU = 16 * 64, I_G = 16 * 88, I_D = 44 * 32, I_ADA = 16 * 192;
    constexpr int NITEMS = 2 * I_IN + 2 * I_O + 2 * I_GLU + 8 * I_G + 4 * I_D + 4 * I_ADA; static_assert(NITEMS == P0_NITEMS && 4 * I_ADA == P0_ADA_ITEMS, "item counts");
    for (int it = lo + wi; it < hi; it += nw) {
        int r = it;
        if (r < 2 * I_IN) { const int e = r / I_IN; p0_transpose_item(I.p[13] + (size_t)e * D * INC, D, INC, (bf16*)(ws + WS_WIN) + (size_t)e * INC * D, 1, 0, scr, r % I_IN, F.lane); continue; } r -= 2 * I_IN;
        if (r < 2 * I_O) { const int e = r / I_O; p0_transpose_item(I.p[18] + (size_t)e * MIXK * D, MIXK, D, (bf16*)(ws + WS_WO) + (size_t)e * D * MIXK, 0, 0, scr, r % I_O, F.lane); continue; } r -= 2 * I_O;
        if (r < 2 * I_GLU) { const int e = r / I_GLU; p0_transpose_item(I.p[27] + (size_t)e * D * 2 * D, D, 2 * D, (bf16*)(ws + WS_WGLU) + (size_t)e * 2 * D * D, 4, 0, scr, r % I_GLU, F.lane); continue; } r -= 2 * I_GLU;
        if (r < 4 * I_G) { const int e = r / I_G; p0_transpose_item(I.p[29] + (size_t)e * D * FF, D, FF, (bf16*)(ws + WS_WGU) + (size_t)e * 2 * FF * D, 2, 0, scr, r % I_G, F.lane); continue; } r -= 4 * I_G;
        if (r < 4 * I_G) { const int e = r / I_G; p0_transpose_item(I.p[30] + (size_t)e * D * FF, D, FF, (bf16*)(ws + WS_WGU) + (size_t)e * 2 * FF * D, 3, 0, scr, r % I_G, F.lane); continue; } r -= 4 * I_G;
        if (r < 4 * I_D) { const int e = r / I_D; p0_transpose_item(I.p[31] + (size_t)e * FF * D, FF, D, (bf16*)(ws + WS_WD) + (size_t)e * D * FF, 0, 0, scr, r % I_D, F.lane); continue; } r -= 4 * I_D;
        { const int e = r / I_ADA; p0_transpose_item(I.p[11] + (size_t)e * D * 6144, D, 6144, (bf16*)(ws + WS_WADA), 0, e * 6144, scr, r % I_ADA, F.lane); }
    }
}
DI void p0_prologue(Frame& F, const Ins& I) {
    PH_IDS(F);
    unsigned char* ws = F.ws;
    p0_items(F, I, P0_NITEMS - P0_ADA_ITEMS, P0_NITEMS, F.gw, F.NGW);
    const int gt = F.gw * 64 + F.lane, NGT = F.NGW * 64;
    { bf16* sc = (bf16*)(ws + WS_SILC);
      for (int i = gt; i < 256 * D; i += NGT) { const int r = i >> 10, c = i & 1023; float v = 0.f;
          if (r < NB_P) v = I.p[7][r * D + c]; else if (r < NBT) v = I.p[8][(r - NB_P) * D + c];
          sc[i] = (bf16)f2bf(v * sigmoidf_(v)); } }
    { float* rt = (float*)(ws + WS_ROPE);
      for (int i = gt; i < 4096 * 8; i += NGT) { const int pos = i >> 3, k = i & 7;
          const double inv = exp_small(-(double)k * (13.122363377404328 / 8.0)); double s, c; sincos_d((double)pos * inv, s, c);
          rt[pos * 16 + k] = (float)c; rt[pos * 16 + 8 + k] = (float)s; } }
    { float* AB = (float*)(ws + WS_S5AB); float* ABT = (float*)(ws + WS_S5ABT); float* BB = (float*)(ws + WS_S5BB);
      for (int i = gt; i < 2 * 64 * 64; i += NGT) { const int og = i >> 6;
          const double lr = I.p[19][i], li = I.p[20][i], dt = exp_small((double)I.p[21][og]);
          const double mag = exp_small(lr * dt); double sn, cs; sincos_d(li * dt, sn, cs);
          const double abr = mag * cs, abi = mag * sn, den = lr * lr + li * li, nr = abr - 1.0;
          const double fr_ = (nr * lr + abi * li) / den, fi_ = (abi * lr - nr * li) / den;
          AB[2 * i] = (float)abr; AB[2 * i + 1] = (float)abi;
          double pr = abr, pi = abi;
#pragma unroll
          for (int q = 0; q < 7; ++q) { const double t = pr * pr - pi * pi; pi = 2.0 * pr * pi; pr = t; }
          ABT[2 * i] = (float)pr; ABT[2 * i + 1] = (float)pi;
          for (int ch = 0; ch < 16; ++ch) { const double br = I.p[22][(size_t)i * 16 + ch], bi = I.p[23][(size_t)i * 16 + ch];
              BB[(size_t)i * 32 + ch] = (float)(fr_ * br - fi_ * bi); BB[(size_t)i * 32 + 16 + ch] = (float)(fr_ * bi + fi_ * br); } } }
    { const float* cc = I.p[2]; float* o = F.out + O_CONVS;
      for (int i = gt; i < 2 * NB_S * 22 * (CCH / 4); i += NGT) { const int c4 = i & 127, rr = (i >> 7) % 22, bn = (i >> 7) / 22;
          *(f32x4*)(o + ((size_t)bn * 30 + rr) * CCH + 4 * c4) = *(const f32x4*)(cc + ((size_t)bn * 30 + 8 + rr) * CCH + 4 * c4); } }
}

template <bool FINAL>
DI void norm_phase(Frame& F, const void* xp, const void* xs, int xf32, const float* gain, const float* msh, const float* msc, bf16* outb, float* outf, const float* part, int nsl, const float* pgate, bf16* xdst, const float* bglu = nullptr) {
    PH_IDS(F);
    f32x4 g[4];
#pragma unroll
    for (int j = 0; j < 4; ++j) g[j] = *(const f32x4*)(gain + 4 * F.lane + 256 * j);
    auto load_mod = [&](f32x4 (&pa)[4], f32x4 (&pb)[4], int nb) {
        if (!FINAL) { const float* sh = msh + (size_t)nb * MODLD; const float* sc = msc + (size_t)nb * MODLD;
#pragma unroll
            for (int j = 0; j < 4; ++j) { pa[j] = *(const f32x4*)(sc + 4 * F.lane + 256 * j); pb[j] = *(const f32x4*)(sh + 4 * F.lane + 256 * j); } }
    };
    auto finish_row = [&](f32x4 (&vr)[4], int row, const f32x4 (&pa)[4], const f32x4 (&pb)[4], int nbp) {
        float ss = 0.f;
#pragma unroll
        for (int j = 0; j < 4; ++j) ss += (vr[j].x * vr[j].x + vr[j].y * vr[j].y) + (vr[j].z * vr[j].z + vr[j].w * vr[j].w);
        const float rstd = __builtin_amdgcn_rsqf(wave_sum(ss) * (1.f / D) + EPS);
        if (FINAL) {
#pragma unroll
            for (int j = 0; j < 4; ++j) __builtin_nontemporal_store(vr[j] * rstd * g[j], (f32x4*)(outf + (size_t)row * D + 4 * F.lane + 256 * j));
        } else {
            const int nb = row_batch(row); f32x4 qa[4], qb[4];
            if (nb != nbp) load_mod(qa, qb, nb);
            else {
#pragma unroll
                for (int j = 0; j < 4; ++j) { qa[j] = pa[j]; qb[j] = pb[j]; } }
#pragma unroll
            for (int j = 0; j < 4; ++j) { const f32x4 a = qa[j], b = qb[j];
                const f32x4 h = vr[j] * rstd * g[j] * (a + 1.f) + b;
                v2u w; w.x = pk2(h.x, h.y); w.y = pk2(h.z, h.w); st8_wt(outb + (size_t)row * D + 4 * F.lane + 256 * j, w.x, w.y); }
        }
    };
    constexpr int RB = 4;
    int pstart = F.gw, pstride = F.NGW, pend = MP;
    const bool split = F.G * 4 == MS;
    if (nsl > 0 && split) { const int hw = (int)blockIdx.x * 4 + (F.wave & 3); if (F.wave < 4) { pstart = hw; pstride = MS; pend = 4 * MS; } else { pstart = 4 * MS + hw; pstride = MS; } }
    for (int row0 = pstart; row0 < pend; row0 += RB * pstride) {
        f32x4 v[RB][4], pa[4], pb[4]; const int nb0 = row0 >> 12;
        load_mod(pa, pb, nb0);
#pragma unroll
        for (int q = 0; q < RB; ++q) { const int row = row0 + q * pstride;
            if (row < pend) { const size_t roff = (size_t)row * D + 4 * F.lane;
                if (xf32 == 1) {
#pragma unroll
                    for (int j = 0; j < 4; ++j) v[q][j] = *(const f32x4*)((const float*)xp + roff + 256 * j);
                } else {
#pragma unroll
                    for (int j = 0; j < 4; ++j) { const v2u w = *(const v2u*)((const bf16*)xp + roff + 256 * j); v[q][j] = (f32x4){bflo(w.x), bfhi(w.x), bflo(w.y), bfhi(w.y)}; }
                }
            } }
#pragma unroll
        for (int q = 0; q < RB; ++q) { const int row = row0 + q * pstride; if (row < pend) finish_row(v[q], row, pa, pb, nb0); }
    }
    {
#pragma unroll 1
        for (int sr = split ? (F.wave < 4 ? (int)blockIdx.x * 4 + F.wave : MS) : F.gw; sr < MS; sr += F.NGW) { const int row = MP + sr;
            f32x4 v[4], pa[4], pb[4]; const size_t roff = (size_t)sr * D + 4 * F.lane; const int nbs = row_batch(row);
            load_mod(pa, pb, nbs);
            if (xf32 != 0) {
#pragma unroll
                for (int j = 0; j < 4; ++j) v[j] = *(const f32x4*)((const float*)xs + roff + 256 * j);
            } else {
#pragma unroll
                for (int j = 0; j < 4; ++j) { const v2u w = *(const v2u*)((const bf16*)xs + roff + 256 * j); v[j] = (f32x4){bflo(w.x), bfhi(w.x), bflo(w.y), bfhi(w.y)}; }
            }
            if (nsl > 0) {
                const float* pp = part + (size_t)sr * D + 4 * F.lane; const float* gp = pgate + (size_t)row_batch(row) * MODLD + 4 * F.lane;
                f32x4 gt_[4];
#pragma unroll
                for (int j = 0; j < 4; ++j) gt_[j] = *(const f32x4*)(gp + 256 * j);
                f32x4 sacc[4];
                if (bglu) {
                    const float* pq = part + (size_t)sr * (2 * D) + 256 * (F.lane >> 5) + 4 * (F.lane & 31);
                    f32x4 sa[4], sb[4];
#pragma unroll
                    for (int j = 0; j < 4; ++j) { sa[j] = *(const f32x4*)(bglu + 4 * F.lane + 256 * j); sb[j] = *(const f32x4*)(bglu + D + 4 * F.lane + 256 * j); }
#pragma unroll 1
                    for (int sl0 = 0; sl0 < nsl; sl0 += 2) {
                        f32x4 ta[2][4], tb[2][4];
#pragma unroll
                        for (int u = 0; u < 2; ++u) { const int sl = sl0 + u < nsl ? sl0 + u : sl0;
#pragma unroll
                            for (int j = 0; j < 4; ++j) { ta[u][j] = *(const f32x4*)(pq + (size_t)sl * MS * 2 * D + 512 * j); tb[u][j] = *(const f32x4*)(pq + (size_t)sl * MS * 2 * D + 512 * j + 128); } }
#pragma unroll
                        for (int u = 0; u < 2; ++u) if (sl0 + u < nsl) {
#pragma unroll
                            for (int j = 0; j < 4; ++j) { sa[j] += ta[u][j]; sb[j] += tb[u][j]; } }
                    }
#pragma unroll
                    for (int j = 0; j < 4; ++j)
#pragma unroll
                        for (int e = 0; e < 4; ++e) sacc[j][e] = sa[j][e] * sigmoidf_(sb[j][e]);
                } else {
#pragma unroll
                    for (int j = 0; j < 4; ++j) sacc[j] = (f32x4){0.f, 0.f, 0.f, 0.f};
#pragma unroll 1
                    for (int sl0 = 0; sl0 < nsl; sl0 += 4) {
                        f32x4 tp[4][4];
#pragma unroll
                        for (int u = 0; u < 4; ++u) { const int sl = sl0 + u < nsl ? sl0 + u : sl0;
#pragma unroll
                            for (int j = 0; j < 4; ++j) tp[u][j] = *(const f32x4*)(pp + (size_t)sl * MS * D + 256 * j); }
#pragma unroll
                        for (int u = 0; u < 4; ++u) if (sl0 + u < nsl) {
#pragma unroll
                            for (int j = 0; j < 4; ++j) sacc[j] += tp[u][j]; }
                    }
                }
#pragma unroll
                for (int j = 0; j < 4; ++j) { v[j] += gt_[j] * sacc[j];
                    v2u w; w.x = pk2(v[j].x, v[j].y); w.y = pk2(v[j].z, v[j].w); *(v2u*)(xdst + (size_t)row * D + 4 * F.lane + 256 * j) = w;
                    v[j] = (f32x4){bflo(w.x), bfhi(w.x), bflo(w.y), bfhi(w.y)}; }
            }
            finish_row(v, row, pa, pb, nbs);
        }
    }
}

DI float red16(float v) { v += shx<1>(v); v += shx<2>(v); v += shx<4>(v); v += shx<8>(v); return v; }
DI void attn_unit_valu(Frame& F, const float* cbase, int row, int g, int ei) {
    const bf16* Qb = (const bf16*)(F.ws + WS_Q); const bf16* Kb = (const bf16*)(F.ws + WS_K); const bf16* Vb = (const bf16*)(F.ws + WS_V);
    const int lane = F.lane, dil = 1 << (2 * g), wb = 128 << (2 * g);
    const v2u qw = *(const v2u*)(Qb + (size_t)row * ATW + g * 256 + 4 * lane);
    const float q0 = bflo(qw.x), q1 = bfhi(qw.x), q2 = bflo(qw.y), q3 = bfhi(qw.y);
    float m = -1e30f, l = 0.f, a0 = 0.f, a1 = 0.f, a2 = 0.f, a3 = 0.f;
    if (row < MP) {
        const int n = row >> 12, t = row & (SEQ - 1);
        int nk = t / dil; nk = (nk < 128 ? nk : 128) + 1;
        const bf16* kp = Kb + ((size_t)n * SEQ + t) * ATW + g * 256 + 4 * lane; const bf16* vp = Vb + ((size_t)n * SEQ + t) * ATW + g * 256 + 4 * lane;
        const ptrdiff_t step = -(ptrdiff_t)dil * ATW;
#pragma unroll 4
        for (int j = 0; j < nk; ++j) {
            const v2u kw = *(const v2u*)(kp + j * step), vw = *(const v2u*)(vp + j * step);
            float s = q0 * bflo(kw.x) + q1 * bfhi(kw.x) + q2 * bflo(kw.y) + q3 * bfhi(kw.y);
            s = red16(s);
            const float mn = fmaxf(m, s), al = fast_exp2(m - mn), p = fast_exp2(s - mn);
            l = l * al + p; a0 = a0 * al + p * bflo(vw.x); a1 = a1 * al + p * bfhi(vw.x); a2 = a2 * al + p * bflo(vw.y); a3 = a3 * al + p * bfhi(vw.y); m = mn;
        }
    } else {
        const int n = (row - MP) >> 3, t = row & 7;
        const float* cache = cbase + ((size_t)(ei * NB_S + n) * wb) * 512;
        const float* fresh = F.out + O_KV0S + (size_t)g * (O_KV1S - O_KV0S) + ((size_t)(ei * NB_S + n) * 8) * 512;
#pragma unroll 4
        for (int j = 0; j <= 128; ++j) {
            const int idx = wb + t - dil * j;
            const float* rp = idx >= wb ? fresh + (size_t)(idx - wb) * 512 : cache + (size_t)idx * 512;
            const f32x4 kv = *(const f32x4*)(rp + 4 * lane), vv = *(const f32x4*)(rp + 256 + 4 * lane);
            float s = q0 * kv.x + q1 * kv.y + q2 * kv.z + q3 * kv.w;
            s = red16(s);
            const float mn = fmaxf(m, s), al = fast_exp2(m - mn), p = fast_exp2(s - mn);
            l = l * al + p; a0 = a0 * al + p * vv.x; a1 = a1 * al + p * vv.y; a2 = a2 * al + p * vv.z; a3 = a3 * al + p * vv.w; m = mn;
        }
    }
    const float inv = 1.f / l;
    float* og = (float*)(F.ws + WS_OG) + ((size_t)g * M + row) * 256 + 4 * lane;
    *(f32x4*)og = (f32x4){a0 * inv, a1 * inv, a2 * inv, a3 * inv};
    if ((lane & 15) == 0) ((float*)(F.ws + WS_LSE))[row < MP ? lse_idx_p(g, row >> 12, lane >> 4, row & (SEQ - 1)) : lse_idx_s(g, row - MP, lane >> 4)] = m + fast_log2(l);
}
DI void attn_phase_v1(Frame& F, const Ins& I, int ei) {
    PH_IDS(F);
    for (int u = F.gw; u < 3 * M; u += F.NGW) { const int g = u / M; const float* cbase = I.p[3]; if (g == 1) cbase = I.p[4]; if (g == 2) cbase = I.p[5]; attn_unit_valu(F, cbase, u - g * M, g, ei); }
}

DI void merge_rows(Frame& F) {
    PH_IDS(F);
    const bf16* OG = (const bf16*)(F.ws + WS_OG); const float* LS = (const float*)(F.ws + WS_LSE); bf16* MX = (bf16*)(F.ws + WS_MIX);
    const int lane = F.lane, h = lane >> 4;
    constexpr int RB = 9;
    for (int row0 = F.gw; row0 < M; row0 += RB * F.NGW) {
        float ls[RB][3]; v2u ug[RB][3];
#pragma unroll
        for (int q = 0; q < RB; ++q) { const int row = row0 + q * F.NGW;
            if (row < M) {
#pragma unroll
                for (int gq = 0; gq < 3; ++gq) { ls[q][gq] = LS[row < MP ? lse_idx_p(gq, row >> 12, h, row & (SEQ - 1)) : lse_idx_s(gq, row - MP, h)]; ug[q][gq] = *(const v2u*)(OG + ((size_t)gq * M + row) * 256 + 4 * lane); } } }
#pragma unroll
        for (int q = 0; q < RB; ++q) { const int row = row0 + q * F.NGW;
            if (row < M) {
                const float mx = fmaxf(ls[q][0], fmaxf(ls[q][1], ls[q][2])); const float w0 = fast_exp2(ls[q][0] - mx), w1 = fast_exp2(ls[q][1] - mx), w2 = fast_exp2(ls[q][2] - mx); const float inv = 1.f / (w0 + w1 + w2);
                const f32x4 o0 = {bflo(ug[q][0].x), bfhi(ug[q][0].x), bflo(ug[q][0].y), bfhi(ug[q][0].y)}, o1 = {bflo(ug[q][1].x), bfhi(ug[q][1].x), bflo(ug[q][1].y), bfhi(ug[q][1].y)}, o2 = {bflo(ug[q][2].x), bfhi(ug[q][2].x), bflo(ug[q][2].y), bfhi(ug[q][2].y)};
                const f32x4 a = (o0 * w0 + o1 * w1 + o2 * w2) * inv;
                st8_wt(MX + (size_t)row * MIXK + CCH + 4 * lane, pk2(a.x, a.y), pk2(a.z, a.w)); } }
    }
}

DI void conv_phase(Frame& F, const Ins& I, int ei) {
    PH_IDS(F);
    const bf16* U = (const bf16*)(F.ws + WS_U); bf16* MX = (bf16*)(F.ws + WS_MIX);
    const float* cw = I.p[14] + (size_t)ei * 31 * CCH; const float* cb = I.p[15] + ei * CCH; const float* lg = I.p[16] + ei * CCH; const float* lb = I.p[17] + ei * CCH;
    LAS unsigned char* tile = F.lds + RING_OFF;
    LAS float* stats = (LAS float*)(F.lds + RING_OFF + 96 * 1024);
    LAS float* mr = stats + 64 * 8;
    const int tid = F.tid, lane = F.lane, wave = F.wave, qd = wave & 3, th = wave >> 2, ch = 128 * qd + 2 * lane;
    typedef __bf16 bf16x2_t __attribute__((ext_vector_type(2)));
    unsigned wa[31], wb[31];
#pragma unroll
    for (int j = 0; j < 31; ++j) { const f32x2 w = *(const f32x2*)(cw + j * CCH + ch); wa[j] = f2bf(w.x); wb[j] = f2bf(w.y) << 16; }
    const f32x2 bias = *(const f32x2*)(cb + ch), lgv = *(const f32x2*)(lg + ch), lbv = *(const f32x2*)(lb + ch);
    constexpr int NPT = MP / 64, NUNITS = NPT + NB_S;
    for (int u = blockIdx.x; u < NUNITS; u += F.G) {
        __syncthreads();
        int nout, orow0;
        if (u < NPT) {
            nout = 64; orow0 = u * 64; const int t0 = orow0 & (SEQ - 1);
            for (int i = tid; i < 94 * 64; i += 512) { const int r = i >> 6, c = i & 63; const int t = t0 - 30 + r;
                v4u v = (v4u){0u, 0u, 0u, 0u}; if (t >= 0) v = *(const v4u*)(U + (size_t)(orow0 - 30 + r) * CCH + 8 * c);
                *(LAS v4u*)(tile + r * 1024 + 16 * c) = v; }
        } else {
            const int n = u - NPT; nout = 8; orow0 = MP + n * 8; const float* hist = I.p[2] + (size_t)(ei * NB_S + n) * 30 * CCH;
            for (int i = tid; i < 38 * 64; i += 512) { const int r = i >> 6, c = i & 63; v4u v;
                if (r < 30) { const f32x4 a = *(const f32x4*)(hist + (size_t)r * CCH + 8 * c), b = *(const f32x4*)(hist + (size_t)r * CCH + 8 * c + 4); v.x = pk2(a.x, a.y); v.y = pk2(a.z, a.w); v.z = pk2(b.x, b.y); v.w = pk2(b.z, b.w); }
                else v = *(const v4u*)(U + (size_t)(orow0 + r - 30) * CCH + 8 * c);
                *(LAS v4u*)(tile + r * 1024 + 16 * c) = v; }
        }
        __syncthreads();
        const int half = nout >> 1, tk0 = th * half;
        float y0[32], y1[32];
#pragma unroll
        for (int k = 0; k < 32; ++k) {
            y0[k] = 0.f; y1[k] = 0.f;
            if (k < half) {
                float s0 = bias.x, s1 = bias.y; const LAS unsigned char* tp = tile + (tk0 + k) * 1024 + 2 * ch;
#pragma unroll
                for (int j = 0; j < 31; ++j) { const unsigned w = *(const LAS unsigned*)(tp + j * 1024);
                    s0 = __builtin_amdgcn_fdot2_f32_bf16(__builtin_bit_cast(bf16x2_t, w), __builtin_bit_cast(bf16x2_t, wa[j]), s0, false);
                    s1 = __builtin_amdgcn_fdot2_f32_bf16(__builtin_bit_cast(bf16x2_t, w), __builtin_bit_cast(bf16x2_t, wb[j]), s1, false); }
                y0[k] = s0; y1[k] = s1;
                const float a = wave_sum(s0 + s1), b = wave_sum(s0 * s0 + s1 * s1);
                if (lane == 0) { stats[((tk0 + k) * 4 + qd) * 2] = a; stats[((tk0 + k) * 4 + qd) * 2 + 1] = b; }
            }
        }
        __syncthreads();
        if (tid < nout) { const LAS float* s = stats + tid * 8; const float sm = (s[0] + s[2]) + (s[4] + s[6]), sq = (s[1] + s[3]) + (s[5] + s[7]);
            const float mean = sm * (1.f / CCH), var = sq * (1.f / CCH) - mean * mean; mr[tid * 2] = mean; mr[tid * 2 + 1] = __builtin_amdgcn_rsqf(fmaxf(var, 0.f) + EPS); }
        __syncthreads();
#pragma unroll
        for (int k = 0; k < 32; ++k) {
            if (k < half) { const float mean = mr[(tk0 + k) * 2], rstd = mr[(tk0 + k) * 2 + 1];
                float z0 = (y0[k] - mean) * rstd * lgv.x + lbv.x, z1 = (y1[k] - mean) * rstd * lgv.y + lbv.y;
                z0 = z0 * sigmoidf_(z0); z1 = z1 * sigmoidf_(z1);
                *(unsigned*)(MX + (size_t)(orow0 + tk0 + k) * MIXK + ch) = pk2(z0, z1); }
        }
    }
    __syncthreads();
}

typedef pg8::bf16x8 bf16x8;
typedef float f32x16 __attribute__((ext_vector_type(16)));
typedef short s16x4 __attribute__((ext_vector_type(4)));
#define MFMA32(a, b, c) __builtin_amdgcn_mfma_f32_32x32x16_bf16((a), (b), (c), 0, 0, 0)
DI int crow(int reg, int h2) { return (reg & 3) + 8 * (reg >> 2) + 4 * h2; }
DI bf16x8 pack_step(const f32x16& x, int s) {
    v4u p;
    p.x = pg8::cvt_pk_bf16(x[8 * s], x[8 * s + 1]); p.y = pg8::cvt_pk_bf16(x[8 * s + 2], x[8 * s + 3]); p.z = pg8::cvt_pk_bf16(x[8 * s + 4], x[8 * s + 5]); p.w = pg8::cvt_pk_bf16(x[8 * s + 6], x[8 * s + 7]);
    return __builtin_bit_cast(bf16x8, p);
}
constexpr int VROWB = 144;
DI void attn_prompt_unit(Frame& F, int unit, LAS unsigned char* vl) {
    const bf16* Qb = (const bf16*)(F.ws + WS_Q); const bf16* Kb = (const bf16*)(F.ws + WS_K); const bf16* Vb = (const bf16*)(F.ws + WS_V);
    const int lane = F.lane, c = lane & 31, h2 = lane >> 5;
    const int qt = unit & 127, ngh = unit >> 7, h = ngh & 3, ng = ngh >> 2, g = ng % 3, n = ng / 3;
    const int sh = 2 * g, dil = 1 << sh, tpr = 128 >> sh;
    const int r = qt / tpr, j = qt - r * tpr;
    const size_t rowbase = (size_t)n * SEQ + r;
    const int coloff = g * 256 + h * 64 + 8 * h2;
    bf16x8 qf[4];
    { const bf16* qp = Qb + (rowbase + (size_t)(32 * j + c) * dil) * ATW + coloff;
#pragma unroll
      for (int s = 0; s < 4; ++s) qf[s] = *(const bf16x8*)(qp + 16 * s); }
    bf16x8 kf[5][4];
#pragma unroll
    for (int kt = 0; kt < 5; ++kt) { const int kb = j - 4 + kt; const int kbc = kb < 0 ? 0 : kb;
        const bf16* kp = Kb + (rowbase + (size_t)(32 * kbc + c) * dil) * ATW + coloff;
#pragma unroll
        for (int s = 0; s < 4; ++s) kf[kt][s] = *(const bf16x8*)(kp + 16 * s); }
    f32x16 S[5];
#pragma unroll
    for (int kt = 0; kt < 5; ++kt) {
        const int kb = j - 4 + kt;
        f32x16 a;
#pragma unroll
        for (int i = 0; i < 16; ++i) a[i] = 0.f;
#pragma unroll
        for (int s = 0; s < 4; ++s) a = MFMA32(kf[kt][s], qf[s], a);
        if (kt == 0) {
#pragma unroll
            for (int i = 0; i < 16; ++i) a[i] = crow(i, h2) >= c ? a[i] : -1e30f;
        }
        if (kt == 4) {
#pragma unroll
            for (int i = 0; i < 16; ++i) a[i] = crow(i, h2) <= c ? a[i] : -1e30f;
        }
        if (kb < 0) {
#pragma unroll
            for (int i = 0; i < 16; ++i) a[i] = -1e30f;
        }
        S[kt] = a;
    }
    bf16x8 vf[5][4];
#pragma unroll
    for (int kt = 0; kt < 5; ++kt) { const int kb = j - 4 + kt; const int kbc = kb < 0 ? 0 : kb;
        const bf16* vp = Vb + (rowbase + (size_t)(32 * kbc + c) * dil) * ATW + coloff;
#pragma unroll
        for (int s = 0; s < 4; ++s) vf[kt][s] = *(const bf16x8*)(vp + 16 * s); }
    float m = -1e30f;
#pragma unroll
    for (int kt = 0; kt < 5; ++kt)
#pragma unroll
        for (int i = 0; i < 16; ++i) m = fmaxf(m, S[kt][i]);
    m = max32(m);
    float l = 0.f;
#pragma unroll
    for (int kt = 0; kt < 5; ++kt)
#pragma unroll
        for (int i = 0; i < 16; ++i) { const float p = fast_exp2(S[kt][i] - m); S[kt][i] = p; l += p; }
    l = sum32(l);
    f32x16 o0, o1;
#pragma unroll
    for (int i = 0; i < 16; ++i) { o0[i] = 0.f; o1[i] = 0.f; }
    const unsigned wbase = (unsigned)(size_t)vl + (unsigned)(c * VROWB + 16 * h2);
    const int q4 = (lane & 15) >> 2, p4 = lane & 3, gid = (lane >> 4) & 1;
    const unsigned rbase = (unsigned)(size_t)vl + (unsigned)((4 * h2 + q4) * VROWB + (16 * gid + 4 * p4) * 2);
#pragma unroll
    for (int kt = 0; kt < 5; ++kt) {
        const int kb = j - 4 + kt;
        if (kb >= 0) {
#pragma unroll
            for (int s = 0; s < 4; ++s) *(LAS bf16x8*)(size_t)(wbase + 32 * s) = vf[kt][s];
            s16x4 t[8];
            asm volatile("s_waitcnt lgkmcnt(0)\n\t"
                         "ds_read_b64_tr_b16 %0, %8\n\tds_read_b64_tr_b16 %1, %8 offset:1152\n\t"
                         "ds_read_b64_tr_b16 %2, %8 offset:64\n\tds_read_b64_tr_b16 %3, %8 offset:1216\n\t"
                         "ds_read_b64_tr_b16 %4, %8 offset:2304\n\tds_read_b64_tr_b16 %5, %8 offset:3456\n\t"
                         "ds_read_b64_tr_b16 %6, %8 offset:2368\n\tds_read_b64_tr_b16 %7, %8 offset:3520\n\t"
                         "s_waitcnt lgkmcnt(0)"
                         : "=&v"(t[0]), "=&v"(t[1]), "=&v"(t[2]), "=&v"(t[3]), "=&v"(t[4]), "=&v"(t[5]), "=&v"(t[6]), "=&v"(t[7]) : "v"(rbase) : "memory");
            const bf16x8 p0 = pack_step(S[kt], 0), p1 = pack_step(S[kt], 1);
            o0 = MFMA32(__builtin_shufflevector(t[0], t[1], 0, 1, 2, 3, 4, 5, 6, 7), p0, o0);
            o1 = MFMA32(__builtin_shufflevector(t[2], t[3], 0, 1, 2, 3, 4, 5, 6, 7), p0, o1);
            o0 = MFMA32(__builtin_shufflevector(t[4], t[5], 0, 1, 2, 3, 4, 5, 6, 7), p1, o0);
            o1 = MFMA32(__builtin_shufflevector(t[6], t[7], 0, 1, 2, 3, 4, 5, 6, 7), p1, o1);
        }
    }
    const float inv = 1.f / l;
    const size_t row = rowbase + (size_t)(32 * j + c) * dil;
    bf16* og = (bf16*)(F.ws + WS_OG) + ((size_t)g * M + row) * 256 + h * 64 + 4 * h2;
#pragma unroll
    for (int k = 0; k < 4; ++k) {
        v2u w; w.x = pg8::cvt_pk_bf16(o0[4 * k] * inv, o0[4 * k + 1] * inv); w.y = pg8::cvt_pk_bf16(o0[4 * k + 2] * inv, o0[4 * k + 3] * inv); *(v2u*)(og + 8 * k) = w;
        w.x = pg8::cvt_pk_bf16(o1[4 * k] * inv, o1[4 * k + 1] * inv); w.y = pg8::cvt_pk_bf16(o1[4 * k + 2] * inv, o1[4 * k + 3] * inv); *(v2u*)(og + 32 + 8 * k) = w;
    }
    if (h2 == 0) ((float*)(F.ws + WS_LSE))[lse_idx_p(g, n, h, r + (32 * j + c) * dil)] = m + fast_log2(l);
}

struct SmState { float m, l, a0, a1, a2, a3; };
DI void sm_init(SmState& s) { s.m = -1e30f; s.l = 0.f; s.a0 = s.a1 = s.a2 = s.a3 = 0.f; }
DI void sm_step(SmState& s, const f32x4 q, const f32x4 k, const f32x4 v, bool valid) {
    float sc = q.x * k.x + q.y * k.y + q.z * k.z + q.w * k.w;
    sc = red16(sc);
    sc = valid ? sc : -1e30f;
    const float mn = fmaxf(s.m, sc), al = fast_exp2(s.m - mn), p = valid ? fast_exp2(sc - mn) : 0.f;
    s.l = s.l * al + p; s.a0 = s.a0 * al + p * v.x; s.a1 = s.a1 * al + p * v.y; s.a2 = s.a2 * al + p * v.z; s.a3 = s.a3 * al + p * v.w; s.m = mn;
}
DI void sm_store(Frame& F, const SmState& s, int g, int row) {
    const float inv = 1.f / s.l;
    { v2u w; w.x = pk2(s.a0 * inv, s.a1 * inv); w.y = pk2(s.a2 * inv, s.a3 * inv); *(v2u*)((bf16*)(F.ws + WS_OG) + ((size_t)g * M + row) * 256 + 4 * F.lane) = w; }
    if ((F.lane & 15) == 0) ((float*)(F.ws + WS_LSE))[lse_idx_s(g, row - MP, F.lane >> 4)] = s.m + fast_log2(s.l);
}
DI f32x4 ldq(const bf16* Qb, int row, int g, int lane) { const v2u w = *(const v2u*)(Qb + (size_t)row * ATW + g * 256 + 4 * lane); return (f32x4){bflo(w.x), bfhi(w.x), bflo(w.y), bfhi(w.y)}; }
DI void attn_sample_unit(Frame& F, const Ins& I, int unit, int ei) {
    const bf16* Qb = (const bf16*)(F.ws + WS_Q);
    const int lane = F.lane, n = unit >> 4, su = unit & 15;
    const int row0 = MP + n * 8;
    if (su < 8) {
        const int t = su; const f32x4 q = ldq(Qb, row0 + t, 2, lane);
        const float* cache = I.p[5] + ((size_t)(ei * NB_S + n) * 2048 + t) * 512 + 4 * lane;
        const float* fresh = F.out + O_KV2S + ((size_t)(ei * NB_S + n) * 8 + t) * 512 + 4 * lane;
        SmState s; sm_init(s);
#pragma unroll 1
        for (int i0 = 0; i0 < 128; i0 += 8) { f32x4 kk[8], vv[8];
#pragma unroll
            for (int u = 0; u < 8; ++u) { const float* rp = cache + (size_t)(i0 + u) * 16 * 512; kk[u] = __builtin_nontemporal_load((const f32x4*)rp); vv[u] = __builtin_nontemporal_load((const f32x4*)(rp + 256)); }
#pragma unroll
            for (int u = 0; u < 8; ++u) sm_step(s, q, kk[u], vv[u], true); }
        sm_step(s, q, *(const f32x4*)fresh, *(const f32x4*)(fresh + 256), true);
        sm_store(F, s, 2, row0 + t);
    } else if (su < 12) {
        const int r = su - 8; const f32x4 qa = ldq(Qb, row0 + r, 1, lane), qb = ldq(Qb, row0 + r + 4, 1, lane);
        const float* cache = I.p[4] + ((size_t)(ei * NB_S + n) * 512 + r) * 512 + 4 * lane;
        const float* fresh = F.out + O_KV1S + ((size_t)(ei * NB_S + n) * 8) * 512 + 4 * lane;
        SmState sa, sb; sm_init(sa); sm_init(sb);
#pragma unroll 1
        for (int i0 = 0; i0 < 128; i0 += 8) { f32x4 kk[8], vv[8];
#pragma unroll
            for (int u = 0; u < 8; ++u) { const float* rp = cache + (size_t)(i0 + u) * 4 * 512; kk[u] = __builtin_nontemporal_load((const f32x4*)rp); vv[u] = __builtin_nontemporal_load((const f32x4*)(rp + 256)); }
#pragma unroll
            for (int u = 0; u < 8; ++u) { sm_step(sa, qa, kk[u], vv[u], true); sm_step(sb, qb, kk[u], vv[u], (i0 + u) >= 1); } }
        { const float* rp = fresh + (size_t)r * 512; const f32x4 k = *(const f32x4*)rp, v = *(const f32x4*)(rp + 256); sm_step(sa, qa, k, v, true); sm_step(sb, qb, k, v, true); }
        { const float* rp = fresh + (size_t)(r + 4) * 512; sm_step(sb, qb, *(const f32x4*)rp, *(const f32x4*)(rp + 256), true); }
        sm_store(F, sa, 1, row0 + r); sm_store(F, sb, 1, row0 + r + 4);
    } else {
        const int t = 2 * (su - 12); const f32x4 qa = ldq(Qb, row0 + t, 0, lane), qb = ldq(Qb, row0 + t + 1, 0, lane);
        const float* cache = I.p[3] + ((size_t)(ei * NB_S + n) * 128) * 512 + 4 * lane;
        const float* fresh = F.out + O_KV0S + ((size_t)(ei * NB_S + n) * 8) * 512 + 4 * lane;
        SmState sa, sb; sm_init(sa); sm_init(sb);
#pragma unroll 1
        for (int i0 = 0; i0 < 128; i0 += 8) { f32x4 kk[8], vv[8];
#pragma unroll
            for (int u = 0; u < 8; ++u) { const float* rp = cache + (size_t)(i0 + u) * 512; kk[u] = *(const f32x4*)rp; vv[u] = *(const f32x4*)(rp + 256); }
#pragma unroll
            for (int u = 0; u < 8; ++u) { sm_step(sa, qa, kk[u], vv[u], (i0 + u) >= t); sm_step(sb, qb, kk[u], vv[u], (i0 + u) >= t + 1); } }
#pragma unroll 1
        for (int u = 0; u <= t + 1; ++u) { const float* rp = fresh + (size_t)u * 512; const f32x4 k = *(const f32x4*)rp, v = *(const f32x4*)(rp + 256); sm_step(sa, qa, k, v, u <= t); sm_step(sb, qb, k, v, true); }
        sm_store(F, sa, 0, row0 + t); sm_store(F, sb, 0, row0 + t + 1);
    }
}
#ifndef PROBE_SITE
#define PROBE_SITE 0
#endif
#ifndef ATTN_SPLIT_WAVES
#define ATTN_SPLIT_WAVES 0
#endif
#ifndef PROMPT_EVEN_UNITS
#define PROMPT_EVEN_UNITS 0
#endif
DI void conv_phase(Frame& F, const Ins& I, int ei);
DI void attn_phase_v2(Frame& F, const Ins& I, int ei) {
    PH_IDS(F);
    constexpr int NSU = NB_S * 16, NPU = NB_P * 3 * 4 * 128;
    const bool oddwg = ((int)blockIdx.x & 1) != 0;
    if (oddwg) { for (int u = F.gw; u < NSU; u += F.NGW) attn_sample_unit(F, I, u, ei); }
    conv_phase(F, I, ei);
    PH_IDS(F);
    if (!oddwg) { for (int u = F.gw; u < NSU; u += F.NGW) attn_sample_unit(F, I, u, ei); }
    LAS unsigned char* vl = F.lds + RING_OFF + F.wave * (32 * VROWB);
    for (int u = F.gw; u < NPU; u += F.NGW) attn_prompt_unit(F, u, vl);
}

DI void s5_local_phase(Frame& F, int oi) {
    PH_IDS(F);
    const bf16* XN = (const bf16*)(F.ws + WS_XN); const float* AB = (const float*)(F.ws + WS_S5AB) + (size_t)oi * 64 * 64 * 2; const float* BB = (const float*)(F.ws + WS_S5BB) + (size_t)oi * 64 * 64 * 32;
    float* E = (float*)(F.ws + WS_S5E);
    const int p = F.lane;
    for (int u = F.gw; u < NB_P * 32 * 64; u += F.NGW) {
        const int g = u & 63, nc = u >> 6;
        const f32x2 ab = *(const f32x2*)(AB + ((size_t)g * 64 + p) * 2);
        float br[16], bi[16];
#pragma unroll
        for (int q = 0; q < 4; ++q) { const f32x4 a = *(const f32x4*)(BB + ((size_t)g * 64 + p) * 32 + 4 * q), b = *(const f32x4*)(BB + ((size_t)g * 64 + p) * 32 + 16 + 4 * q);
            br[4 * q] = a.x; br[4 * q + 1] = a.y; br[4 * q + 2] = a.z; br[4 * q + 3] = a.w; bi[4 * q] = b.x; bi[4 * q + 1] = b.y; bi[4 * q + 2] = b.z; bi[4 * q + 3] = b.w; }
        float hr = 0.f, hi = 0.f;
        const bf16* up = XN + (size_t)nc * 128 * D + 16 * g;
#pragma unroll 2
        for (int t = 0; t < 128; ++t) {
            const v4u ua = *(const v4u*)(up + (size_t)t * D), ub = *(const v4u*)(up + (size_t)t * D + 8);
            const float uu[16] = {bflo(ua.x), bfhi(ua.x), bflo(ua.y), bfhi(ua.y), bflo(ua.z), bfhi(ua.z), bflo(ua.w), bfhi(ua.w), bflo(ub.x), bfhi(ub.x), bflo(ub.y), bfhi(ub.y), bflo(ub.z), bfhi(ub.z), bflo(ub.w), bfhi(ub.w)};
            float sr = 0.f, si = 0.f;
#pragma unroll
            for (int c = 0; c < 16; ++c) { sr += br[c] * uu[c]; si += bi[c] * uu[c]; }
            const float nr = ab.x * hr - ab.y * hi + sr, ni = ab.x * hi + ab.y * hr + si; hr = nr; hi = ni;
        }
        *(f32x2*)(E + (((size_t)nc * 64 + g) * 64 + p) * 2) = (f32x2){hr, hi};
    }
}
DI void s5_carry_phase(Frame& F, int oi) {
    PH_IDS(F);
    const float* ABT = (const float*)(F.ws + WS_S5ABT) + (size_t)oi * 64 * 64 * 2; const float* E = (const float*)(F.ws + WS_S5E); float* SIN = (float*)(F.ws + WS_S5SIN);
    const int gt = F.gw * 64 + F.lane;
    if (gt < NB_P * 64 * 64) {
        const int n = gt >> 12, gp = gt & 4095;
        const f32x2 a = *(const f32x2*)(ABT + (size_t)gp * 2);
        f32x2 e[32];
#pragma unroll
        for (int c = 0; c < 32; ++c) e[c] = *(const f32x2*)(E + (((size_t)(n * 32 + c)) * 4096 + gp) * 2);
        float sr, si; asm volatile("v_mov_b32 %0, 0\n\tv_mov_b32 %1, 0" : "=v"(sr), "=v"(si));
#pragma unroll
        for (int c = 0; c < 32; ++c) { const size_t o = (((size_t)(n * 32 + c)) * 4096 + gp) * 2;
            *(f32x2*)(SIN + o) = (f32x2){sr, si};
            const float nr = a.x * sr - a.y * si + e[c].x, ni = a.x * si + a.y * sr + e[c].y; sr = nr; si = ni; }
        *(f32x2*)(F.out + O_S5P + ((size_t)(oi * NB_P + n) * 4096 + gp) * 2) = (f32x2){sr, si};
    }
}
DI void s5_out_phase(Frame& F, const Ins& I, int oi) {
    PH_IDS(F);
    const bf16* XN = (const bf16*)(F.ws + WS_XN); bf16* ZZ = (bf16*)(F.ws + WS_ZZ);
    const float* AB = (const float*)(F.ws + WS_S5AB) + (size_t)oi * 64 * 64 * 2; const float* BB = (const float*)(F.ws + WS_S5BB) + (size_t)oi * 64 * 64 * 32; const float* SIN = (const float*)(F.ws + WS_S5SIN);
    const float* Cr = I.p[24] + (size_t)oi * 64 * 16 * 64; const float* Ci = I.p[25] + (size_t)oi * 64 * 16 * 64; const float* Dk = I.p[26] + (size_t)oi * D;
    LAS float* hs = (LAS float*)(F.lds + RING_OFF + F.wave * 1024);
    const int p = F.lane, hch = F.lane >> 2, q = F.lane & 3;
    constexpr int NPU = NB_P * 32 * 64, NSU = NB_S * 64;
    for (int u = F.gw; u < NPU + NSU; u += F.NGW) {
        int g, row0, T; f32x2 h0;
        if (u < NPU) { g = u & 63; const int nc = u >> 6; row0 = nc * 128; T = 128; h0 = *(const f32x2*)(SIN + (((size_t)nc * 64 + g) * 64 + p) * 2); }
        else { const int v = u - NPU; g = v & 63; const int n = v >> 6; row0 = MP + n * 8; T = 8; h0 = *(const f32x2*)(I.p[6] + (((size_t)(oi * NB_S + n) * 64 + g) * 64 + p) * 2); }
        const f32x2 ab = *(const f32x2*)(AB + ((size_t)g * 64 + p) * 2);
        float br[16], bi[16], cr[16], ci[16];
#pragma unroll
        for (int k = 0; k < 4; ++k) { const f32x4 a = *(const f32x4*)(BB + ((size_t)g * 64 + p) * 32 + 4 * k), b = *(const f32x4*)(BB + ((size_t)g * 64 + p) * 32 + 16 + 4 * k);
            br[4 * k] = a.x; br[4 * k + 1] = a.y; br[4 * k + 2] = a.z; br[4 * k + 3] = a.w; bi[4 * k] = b.x; bi[4 * k + 1] = b.y; bi[4 * k + 2] = b.z; bi[4 * k + 3] = b.w;
            const f32x4 c = *(const f32x4*)(Cr + ((size_t)g * 16 + hch) * 64 + 16 * q + 4 * k), d = *(const f32x4*)(Ci + ((size_t)g * 16 + hch) * 64 + 16 * q + 4 * k);
            cr[4 * k] = c.x; cr[4 * k + 1] = c.y; cr[4 * k + 2] = c.z; cr[4 * k + 3] = c.w; ci[4 * k] = d.x; ci[4 * k + 1] = d.y; ci[4 * k + 2] = d.z; ci[4 * k + 3] = d.w; }
        const float dsk = Dk[16 * g + hch];
        float hr = h0.x, hi = h0.y;
        const bf16* up = XN + (size_t)row0 * D + 16 * g;
        for (int t = 0; t < T; ++t) {
            const v4u ua = *(const v4u*)(up + (size_t)t * D), ub = *(const v4u*)(up + (size_t)t * D + 8);
            const float uu[16] = {bflo(ua.x), bfhi(ua.x), bflo(ua.y), bfhi(ua.y), bflo(ua.z), bfhi(ua.z), bflo(ua.w), bfhi(ua.w), bflo(ub.x), bfhi(ub.x), bflo(ub.y), bfhi(ub.y), bflo(ub.z), bfhi(ub.z), bflo(ub.w), bfhi(ub.w)};
            const float um = bf2f(up[(size_t)t * D + hch]);
            float sr = 0.f, si = 0.f;
#pragma unroll
            for (int c = 0; c < 16; ++c) { sr += br[c] * uu[c]; si += bi[c] * uu[c]; }
            const float nr = ab.x * hr - ab.y * hi + sr, ni = ab.x * hi + ab.y * hr + si; hr = nr; hi = ni;
            hs[p] = hr; hs[64 + p] = hi;
            LDS_WAIT();
            float y = 0.f;
#pragma unroll
            for (int k = 0; k < 4; ++k) { const f32x4 a = *(const LAS f32x4*)(hs + 16 * q + 4 * k), b = *(const LAS f32x4*)(hs + 64 + 16 * q + 4 * k);
                y += cr[4 * k] * a.x + cr[4 * k + 1] * a.y + cr[4 * k + 2] * a.z + cr[4 * k + 3] * a.w;
                y -= ci[4 * k] * b.x + ci[4 * k + 1] * b.y + ci[4 * k + 2] * b.z + ci[4 * k + 3] * b.w; }
            LDS_WAIT();
            y += shx<1>(y); y += shx<2>(y);
            if (q == 0) { const float z = gelu_tanh(y + dsk * um); ZZ[(size_t)(row0 + t) * D + 16 * g + hch] = (bf16)f2bf(z); }
        }
        if (u >= NPU) { const int v = u - NPU, n = v >> 6; *(f32x2*)(F.out + O_S5S + (((size_t)(oi * NB_S + n) * 64 + g) * 64 + p) * 2) = (f32x2){hr, hi}; }
    }
}

constexpr size_t WS_S5BF = WS_END;
constexpr size_t WS_S5CF = WS_S5BF + 512 * 1024;
constexpr size_t WS_S5DF = WS_S5CF + 1 * MiB;
constexpr size_t WS_PART = WS_S5DF + 256 * 1024;
constexpr size_t WS_PART2 = WS_PART + 44 * MiB;
constexpr size_t XNSZ = 34 * MiB, WS_XNB = WS_PART2 + 32 * MiB;
constexpr size_t WS_END2 = WS_XNB + 8 * XNSZ;
static_assert((size_t)M * D * 2 == XNSZ, "XN buffer size");

DI void s5_tables_bf16(Frame& F, const Ins& I) {
    bf16* BF = (bf16*)(F.ws + WS_S5BF); bf16* CF = (bf16*)(F.ws + WS_S5CF); bf16* DF = (bf16*)(F.ws + WS_S5DF);
    const int gt = F.gw * 64 + F.lane, NGT = F.NGW * 64;
    for (int i = gt; i < 2 * 64 * 4 * 64; i += NGT) {
        const int ln = i & 63, T = (i >> 6) & 3, og = i >> 8, ph = T >> 1, ri = T & 1, p = 32 * ph + (ln & 31), h2 = ln >> 5;
        const int ip = og * 64 + p;
        const double lr = I.p[19][ip], li = I.p[20][ip], dt = exp_small((double)I.p[21][og]);
        const double mag = exp_small(lr * dt); double sn, cs; sincos_d(li * dt, sn, cs);
        const double abr = mag * cs, abi = mag * sn, den = lr * lr + li * li, nr = abr - 1.0;
        const double fr_ = (nr * lr + abi * li) / den, fi_ = (abi * lr - nr * li) / den;
        unsigned w[4];
#pragma unroll
        for (int jj = 0; jj < 8; jj += 2) { float v[2];
#pragma unroll
            for (int e = 0; e < 2; ++e) { const int ch = 8 * h2 + jj + e; const double br = I.p[22][(size_t)ip * 16 + ch], bi = I.p[23][(size_t)ip * 16 + ch]; v[e] = (float)(ri == 0 ? fr_ * br - fi_ * bi : fr_ * bi + fi_ * br); }
            w[jj >> 1] = pk2(v[0], v[1]); }
        *(v4u*)(BF + (size_t)i * 8) = (v4u){w[0], w[1], w[2], w[3]};
    }
    for (int i = gt; i < 2 * 64 * 8 * 64; i += NGT) {
        const int ln = i & 63, s = (i >> 6) & 7, og = i >> 9, n = ln & 31, h2 = ln >> 5;
        unsigned w[4];
#pragma unroll
        for (int jj = 0; jj < 8; jj += 2) { float v[2];
#pragma unroll
            for (int e = 0; e < 2; ++e) { const int kk = 16 * s + 8 * h2 + jj + e, T = kk >> 5, c = kk & 31, ph = T >> 1, ri = T & 1; float x = 0.f;
                if (n < 16) { const size_t ci = ((size_t)og * 16 + n) * 64 + 32 * ph + c; x = ri == 0 ? I.p[24][ci] : -I.p[25][ci]; }
                v[e] = x; }
            w[jj >> 1] = pk2(v[0], v[1]); }
        *(v4u*)(CF + (size_t)i * 8) = (v4u){w[0], w[1], w[2], w[3]};
    }
    for (int i = gt; i < 2 * 64 * 2 * 64; i += NGT) {
        const int ln = i & 63, hl = (i >> 6) & 1, og = i >> 7, n = ln & 31, h2 = ln >> 5;
        unsigned w[4];
#pragma unroll
        for (int jj = 0; jj < 8; jj += 2) { float v[2];
#pragma unroll
            for (int e = 0; e < 2; ++e) { const int ch = 8 * h2 + jj + e; float x = 0.f;
                if (n < 16 && ch == n) { const float d = I.p[26][(size_t)og * 16 + n]; const float dh = bf2f(f2bf(d)); x = hl == 0 ? dh : d - dh; }
                v[e] = x; }
            w[jj >> 1] = pk2(v[0], v[1]); }
        *(v4u*)(DF + (size_t)i * 8) = (v4u){w[0], w[1], w[2], w[3]};
    }
}

DI int s5_step_of_row(int i) { return (i & 3) + 4 * (i >> 3); }
DI void s5_scan16(f32x16& br, f32x16& bi, const f32x2 a, float& hr, float& hi) {
#pragma unroll
    for (int r = 0; r < 16; ++r) { const float nr = a.x * hr - a.y * hi + br[r], ni = a.x * hi + a.y * hr + bi[r]; hr = nr; hi = ni; br[r] = nr; bi[r] = ni; }
}
DI f32x16 zero16() { f32x16 z;
#pragma unroll
    for (int i = 0; i < 16; ++i) z[i] = 0.f;
    return z; }

template <class T> DI T ldg(const char* ubase, unsigned voff) { return *(const T*)(ubase + voff); }
DI void s5_local_phase2(Frame& F, int oi) {
    PH_IDS(F);
    const char* XNc = (const char*)(F.ws + WS_XNB + (size_t)(4 * oi + 2) * XNSZ);
    const char* ABc = (const char*)(F.ws + WS_S5AB) + (size_t)oi * 64 * 64 * 8; char* Ec = (char*)(F.ws + WS_S5E);
    const char* BFc = (const char*)(F.ws + WS_S5BF) + (size_t)oi * 64 * 4 * 64 * 16;
    const int lane = F.lane, c = lane & 31, h2 = lane >> 5;
    const int arow_seg = (c >> 2) & 1, arow_step = s5_step_of_row(c);
    const unsigned o_frag = lane * 16, o_c8 = c * 8, o_c8seg = c * 8 + h2 * (64 * 64 * 8), o_arow = ((arow_seg * 128 + arow_step) * D + 8 * h2) * 2;
    constexpr int NU = NB_P * 64 * 16;
    auto xbase = [&](int uu) { const int g = uu & 63, k = (uu >> 6) & 15, n = uu >> 10; return XNc + (((size_t)n * SEQ + (size_t)k * 256) * D + 16 * g) * 2; };
    bf16x8 afq[8], bf[4]; f32x2 a0 = (f32x2){0.f, 0.f}, a1 = (f32x2){0.f, 0.f}; int gcur = -1;
    if (F.gw < NU) { const char* xb = xbase(F.gw);
#pragma unroll
        for (int b = 0; b < 8; ++b) afq[b] = ldg<bf16x8>(xb + (size_t)b * (16 * D * 2), o_arow); }
    for (int u = F.gw; u < NU; u += F.NGW) {
        const int g = u & 63, k = (u >> 6) & 15, n = u >> 10;
        if (g != gcur) { gcur = g; const char* bfb = BFc + (size_t)g * (4 * 64 * 16);
#pragma unroll
            for (int T = 0; T < 4; ++T) bf[T] = ldg<bf16x8>(bfb + T * 1024, o_frag);
            const char* abb = ABc + (size_t)g * 512; a0 = ldg<f32x2>(abb, o_c8); a1 = ldg<f32x2>(abb + 256, o_c8); }
        bf16x8 af[8];
#pragma unroll
        for (int b = 0; b < 8; ++b) af[b] = afq[b];
        if (u + F.NGW < NU) { const char* xb = xbase(u + F.NGW);
#pragma unroll
            for (int b = 0; b < 8; ++b) afq[b] = ldg<bf16x8>(xb + (size_t)b * (16 * D * 2), o_arow); }
        float hr0 = 0.f, hi0 = 0.f, hr1 = 0.f, hi1 = 0.f;
#pragma unroll
        for (int blk = 0; blk < 8; ++blk) {
            f32x16 r0 = MFMA32(af[blk], bf[0], zero16()), i0 = MFMA32(af[blk], bf[1], zero16()), r1 = MFMA32(af[blk], bf[2], zero16()), i1 = MFMA32(af[blk], bf[3], zero16());
            s5_scan16(r0, i0, a0, hr0, hi0); s5_scan16(r1, i1, a1, hr1, hi1);
        }
        char* eb = Ec + (((size_t)(n * 32 + 2 * k) * 64 + g) * 64) * 8;
        st8_wt(eb + o_c8seg, __builtin_bit_cast(unsigned, hr0), __builtin_bit_cast(unsigned, hi0)); st8_wt(eb + 256 + o_c8seg, __builtin_bit_cast(unsigned, hr1), __builtin_bit_cast(unsigned, hi1));
    }
}

DI void s5_out_phase2(Frame& F, const Ins& I, int oi) {
    PH_IDS(F);
    const char* XNc = (const char*)(F.ws + WS_XNB + (size_t)(4 * oi + 2) * XNSZ);
    char* ZZc = (char*)(F.ws + WS_ZZ);
    const char* ABc = (const char*)(F.ws + WS_S5AB) + (size_t)oi * 64 * 64 * 8; const char* Ec = (const char*)(F.ws + WS_S5E); const char* ABTc = (const char*)(F.ws + WS_S5ABT) + (size_t)oi * 64 * 64 * 8; char* SPc = (char*)(F.out + O_S5P) + (size_t)oi * NB_P * 64 * 64 * 8;
    const char* BFc = (const char*)(F.ws + WS_S5BF) + (size_t)oi * 64 * 4 * 64 * 16; const char* CFc = (const char*)(F.ws + WS_S5CF) + (size_t)oi * 64 * 8 * 64 * 16; const char* DFc = (const char*)(F.ws + WS_S5DF) + (size_t)oi * 64 * 2 * 64 * 16;
    const char* STi = (const char*)(I.p[6]) + (size_t)oi * NB_S * 64 * 64 * 8; char* STo = (char*)(F.out + O_S5S) + (size_t)oi * NB_S * 64 * 64 * 8;
    const int lane = F.lane, c = lane & 31, h2 = lane >> 5;
    const int arow_seg = (c >> 2) & 1, arow_step = s5_step_of_row(c);
    const int erow = lane >> 1, erow_seg = (erow >> 2) & 1, erow_step = s5_step_of_row(erow);
    LAS unsigned char* img = F.lds + RING_OFF + F.wave * 8192;
    const unsigned wimg = (unsigned)(size_t)img + (unsigned)(c * 64 + 8 * h2);
    const int q4 = (lane & 15) >> 2, p4 = lane & 3, blk16 = (lane >> 4) & 1;
    const unsigned rimg = (unsigned)(size_t)img + (unsigned)((8 * h2 + q4) * 64 + 8 * (4 * blk16 + p4));
    const unsigned yimg_w = (unsigned)(size_t)img + (unsigned)(c * 4 + 4 * h2 * 64), yimg_r = (unsigned)(size_t)img + (unsigned)(erow * 64 + (lane & 1) * 32);
    const unsigned o_frag = lane * 16, o_c8 = c * 8;
    const unsigned o_c8seg = c * 8 + h2 * (64 * 64 * 8), o_c8smp = c * 8 + h2 * (2 * 64 * 64 * 8);
    const unsigned o_arow_p = ((arow_seg * 128 + arow_step) * D + 8 * h2) * 2, o_arow_s = ((arow_seg * 16 + arow_step) * D + 8 * h2) * 2;
    const unsigned o_erow_p = ((erow_seg * 128 + erow_step) * D + 8 * (lane & 1)) * 2, o_erow_s = ((erow_seg * 16 + erow_step) * D + 8 * (lane & 1)) * 2;
    constexpr int NPU = NB_P * 64 * 16, NSU = (NB_S / 4) * 64;
    for (int u = F.gw; u < NPU + NSU; u += F.NGW) {
        const bool samp = u >= NPU;
        int g, nblk; const char* xb; char* zb; const char* sib; char* sob = nullptr; unsigned o_arow, o_erow, o_st;
        if (!samp) { g = u & 63; const int k = (u >> 6) & 15, n = u >> 10; nblk = 8;
            const size_t tb = (((size_t)n * SEQ + (size_t)k * 256) * D + 16 * g) * 2; xb = XNc + tb; zb = ZZc + tb;
            sib = nullptr; o_arow = o_arow_p; o_erow = o_erow_p; o_st = o_c8seg;
        } else { const int v = u - NPU; g = v & 63; const int tile = v >> 6; nblk = 1;
            const size_t tb = (((size_t)MP + (size_t)tile * 32) * D + 16 * g) * 2; xb = XNc + tb; zb = ZZc + tb;
            sib = STi + (((size_t)(4 * tile) * 64 + g) * 64) * 8; sob = STo + (((size_t)(4 * tile) * 64 + g) * 64) * 8; o_arow = o_arow_s; o_erow = o_erow_s; o_st = o_c8smp;
        }
        float hr0, hi0, hr1, hi1; int kfin = -1; char* spo = nullptr;
        if (samp) { const f32x2 s0 = ldg<f32x2>(sib, o_st), s1 = ldg<f32x2>(sib + 256, o_st); hr0 = s0.x; hi0 = s0.y; hr1 = s1.x; hi1 = s1.y; }
        else {
            const int k = (u >> 6) & 15, n = u >> 10, seg = 2 * k + h2; kfin = k; spo = SPc + (((size_t)n * 64 + g) * 64) * 8;
            const char* eb = Ec + (((size_t)(n * 32) * 64 + g) * 64) * 8; const char* abtb = ABTc + (size_t)g * 512;
            const f32x2 t0 = ldg<f32x2>(abtb, o_c8), t1 = ldg<f32x2>(abtb + 256, o_c8);
            hr0 = 0.f; hi0 = 0.f; hr1 = 0.f; hi1 = 0.f;
#pragma unroll
            for (int half = 0; half < 2; ++half) {
                f32x2 e0[16], e1[16];
#pragma unroll
                for (int q = 0; q < 16; ++q) { const int cc = 16 * half + q < 31 ? 16 * half + q : 30; e0[q] = ldg<f32x2>(eb + (size_t)cc * (64 * 64 * 8), o_c8); e1[q] = ldg<f32x2>(eb + (size_t)cc * (64 * 64 * 8) + 256, o_c8); }
#pragma unroll
                for (int q = 0; q < 16; ++q) { const int cc = 16 * half + q;
                    if (cc < seg) { const float n0r = t0.x * hr0 - t0.y * hi0 + e0[q].x, n0i = t0.x * hi0 + t0.y * hr0 + e0[q].y, n1r = t1.x * hr1 - t1.y * hi1 + e1[q].x, n1i = t1.x * hi1 + t1.y * hr1 + e1[q].y;
                        hr0 = n0r; hi0 = n0i; hr1 = n1r; hi1 = n1i; } }
            }
        }
        const char* bfb = BFc + (size_t)g * (4 * 64 * 16); const char* cfb = CFc + (size_t)g * (8 * 64 * 16); const char* dfb = DFc + (size_t)g * (2 * 64 * 16);
        bf16x8 bf[4], cf[8], df[2];
#pragma unroll
        for (int T = 0; T < 4; ++T) bf[T] = ldg<bf16x8>(bfb + T * 1024, o_frag);
#pragma unroll
        for (int s = 0; s < 8; ++s) cf[s] = ldg<bf16x8>(cfb + s * 1024, o_frag);
#pragma unroll
        for (int s = 0; s < 2; ++s) df[s] = ldg<bf16x8>(dfb + s * 1024, o_frag);
        const char* abb = ABc + (size_t)g * 512;
        const f32x2 a0 = ldg<f32x2>(abb, o_c8), a1 = ldg<f32x2>(abb + 256, o_c8);
        bf16x8 afn = ldg<bf16x8>(xb, o_arow);
        for (int blk = 0; blk < nblk; ++blk) {
            const bf16x8 af = afn; afn = ldg<bf16x8>(xb + (size_t)(blk + 1 < nblk ? blk + 1 : blk) * (16 * D * 2), o_arow);
#pragma unroll
            for (int ph = 0; ph < 2; ++ph) {
                const f32x16 br = MFMA32(af, bf[2 * ph], zero16()), bi = MFMA32(af, bf[2 * ph + 1], zero16());
                const f32x2 a = ph ? a1 : a0; float hr = ph ? hr1 : hr0, hi = ph ? hi1 : hi0;
                float xr[16], xi[16];
#pragma unroll
                for (int r = 0; r < 16; ++r) {
                    if (samp && r == 8) {
                        *(f32x2*)(sob + ph * 256 + o_st) = (f32x2){hr, hi};
                        const f32x2 s0 = ldg<f32x2>(sib + 64 * 64 * 8 + ph * 256, o_st); hr = s0.x; hi = s0.y; }
                    const float nr = a.x * hr - a.y * hi + br[r], ni = a.x * hi + a.y * hr + bi[r]; hr = nr; hi = ni; xr[r] = nr; xi[r] = ni;
                }
                if (samp) *(f32x2*)(sob + 64 * 64 * 8 + ph * 256 + o_st) = (f32x2){hr, hi};
                if (ph) { hr1 = hr; hi1 = hi; } else { hr0 = hr; hi0 = hi; }
#pragma unroll
                for (int q = 0; q < 4; ++q) { v2u w;
                    w.x = pg8::cvt_pk_bf16(xr[4 * q], xr[4 * q + 1]); w.y = pg8::cvt_pk_bf16(xr[4 * q + 2], xr[4 * q + 3]); *(LAS v2u*)(size_t)(wimg + (2 * ph) * 2048 + 16 * q) = w;
                    w.x = pg8::cvt_pk_bf16(xi[4 * q], xi[4 * q + 1]); w.y = pg8::cvt_pk_bf16(xi[4 * q + 2], xi[4 * q + 3]); *(LAS v2u*)(size_t)(wimg + (2 * ph + 1) * 2048 + 16 * q) = w; }
                __builtin_amdgcn_sched_barrier(0);
            }
            f32x16 y = MFMA32(af, df[0], zero16()); y = MFMA32(af, df[1], y);
#pragma unroll
            for (int hb = 0; hb < 4; ++hb) {
                s16x4 t[4];
                asm volatile("s_waitcnt lgkmcnt(0)\n\t"
                             "ds_read_b64_tr_b16 %0, %4\n\tds_read_b64_tr_b16 %1, %4 offset:256\n\tds_read_b64_tr_b16 %2, %4 offset:1024\n\tds_read_b64_tr_b16 %3, %4 offset:1280\n\t"
                             "s_waitcnt lgkmcnt(0)"
                             : "=&v"(t[0]), "=&v"(t[1]), "=&v"(t[2]), "=&v"(t[3]) : "v"(rimg + 2048 * hb) : "memory");
#pragma unroll
                for (int s = 0; s < 2; ++s) y = MFMA32(__builtin_shufflevector(t[2 * s], t[2 * s + 1], 0, 1, 2, 3, 4, 5, 6, 7), cf[2 * hb + s], y);
            }
            if (c < 16) {
#pragma unroll
                for (int r = 0; r < 16; ++r) *(LAS float*)(size_t)(yimg_w + (unsigned)(((r & 3) + 8 * (r >> 2)) * 64)) = y[r];
            }
            { f32x4 ya, yb;
              asm volatile("s_waitcnt lgkmcnt(0)\n\tds_read_b128 %0, %2\n\tds_read_b128 %1, %2 offset:16\n\ts_waitcnt lgkmcnt(0)" : "=&v"(ya), "=&v"(yb) : "v"(yimg_r) : "memory");
              f32x4 za, zb2;
#pragma unroll
              for (int e = 0; e < 4; ++e) { za[e] = gelu_tanh(ya[e]); zb2[e] = gelu_tanh(yb[e]); }
              *(v4u*)(zb + (size_t)blk * (16 * D * 2) + o_erow) = pack8(za, zb2); }
        }
        if (kfin == 15 && h2 == 1) { *(f32x2*)(spo + o_c8) = (f32x2){hr0, hi0}; *(f32x2*)(spo + 256 + o_c8) = (f32x2){hr1, hi1}; }
    }
}

#ifndef SITE_P0
#define SITE_P0 1
#endif
#ifndef SITE_ADA
#define SITE_ADA 1
#endif
#ifndef SITE_NORM
#define SITE_NORM 1
#endif
#ifndef SITE_IN
#define SITE_IN 1
#endif
#ifndef SITE_ATTN
#define SITE_ATTN 1
#endif
#ifndef SITE_CONV
#define SITE_CONV 1
#endif
#ifndef SITE_O
#define SITE_O 1
#endif
#ifndef SITE_S5A
#define SITE_S5A 1
#endif
#ifndef SITE_S5B
#define SITE_S5B 1
#endif
#ifndef SITE_S5C
#define SITE_S5C 1
#endif
#ifndef SITE_GLU
#define SITE_GLU 1
#endif
#ifndef SITE_UP
#define SITE_UP 1
#endif
#ifndef SITE_DOWN
#define SITE_DOWN 1
#endif
#ifndef SITE_FINAL
#define SITE_FINAL 1
#endif
#ifndef PROBE_SITE
#define PROBE_SITE 0
#endif
#define REP(id) _Pragma("unroll 1") for (int rep_ = 0; rep_ < ((PROBE_SITE == (id)) ? 2 : 1); ++rep_)
#ifndef GEMM_ALIGN
#define GEMM_ALIGN true
#endif
#ifndef GEMM_SP2
#define GEMM_SP2 true
#endif
#ifndef S5_FUSED
#define S5_FUSED 0
#endif
#ifndef USE_SPLITK
#define USE_SPLITK 1
#endif
constexpr int NPHASES = 35;
#ifndef MK_PER_PHASE
#define MK_PER_PHASE 0
#endif
struct Args { Ins in; float* out; unsigned char* ws; int ph_lo, ph_hi; };
static_assert(sizeof(Args) == 32 * 8 + 8 + 8 + 8, "Args has no padding");

DI bool in_phase(int lo, int hi, int k) { asm volatile("" : "+s"(lo), "+s"(hi)); return lo <= k && k < hi; }
__global__ void __launch_bounds__(NWAVES * 64, 2) trunk_fwd(Args args) {
    extern __shared__ __attribute__((aligned(16))) unsigned char lds[];
    Frame F;
    F.lds = (LAS unsigned char*)lds;
    F.MISC = (volatile LAS unsigned*)(F.lds + MISC_OFF);
    F.wave = __builtin_amdgcn_readfirstlane((int)threadIdx.x >> 6);
    F.G = gridDim.x; F.NGW = F.G * NWAVES;
    F.ws = uni_ptr(args.ws); F.out = uni_ptr(args.out); F.ctl = (gu32*)(F.ws + WS_CTL); PH_IDS(F);
    const Ins& I = args.in;
    for (int u = F.tid; u < (LDS_BYTES - LDSCTL_OFF) / 4; u += NWAVES * 64) ((LAS unsigned*)(F.lds + LDSCTL_OFF))[u] = 0u;
    __syncthreads();
    XcdBarrier bar; bar.bar = (unsigned*)(F.ctl + CW_BAR); bar.x = 0; bar.st = nullptr;
    if (!MK_PER_PHASE) bar = xcd_barrier_post((unsigned*)(F.ctl + CW_BAR), F.MISC + 8);
    const int lo = args.ph_lo, hi = args.ph_hi;
#define IN(k) in_phase(lo, hi, (k))
#ifndef PROBE_SKIP
#define PROBE_SKIP 0
#endif
#define INL(kk) (IN(base + (kk)) && !(li < 0 && ((PROBE_SKIP >> (kk)) & 1)))
#define SEAM1(k, k2) do { if (IN(k) && IN(k2)) { PH_IDS(F); if (MK_PER_PHASE) { if (F.tid == 0) __hip_atomic_store(F.ctl + CW_TMO, 0xBADBA0u, RLX_AGENT); } else xcd_barrier(bar, false, false); } } while (0)
#define SEAMX(k, wb) do { if (IN(k) && IN((k) + 1)) { PH_IDS(F); if (MK_PER_PHASE) { if (F.tid == 0) __hip_atomic_store(F.ctl + CW_TMO, 0xBADBA0u, RLX_AGENT); } else { xcd_barrier(bar, false, wb); if (PROBE_SITE == 13) xcd_barrier(bar); } } } while (0)
#define SEAM(k) SEAMX(k, true)
#define SEAM_WT(k) SEAMX(k, false)
#define WSB(off) (F.ws + (off))
#define XN1p ((bf16*)WSB(WS_XNB + (size_t)(2 * l) * XNSZ))
#define XN2p ((bf16*)WSB(WS_XNB + (size_t)(2 * l + 1) * XNSZ))
#define Xp ((bf16*)WSB(WS_X))
#define XSRC_P (l == 0 ? (const void*)I.p[0] : (const void*)Xp)
#define XSRC_S (l == 0 ? (const void*)I.p[1] : (const void*)(Xp + (size_t)MP * D))
#define MODL ((float*)WSB(WS_MOD) + (size_t)l * 6144)

    if (SITE_P0 && IN(0)) REP(1) { p0_prologue(F, I); s5_tables_bf16(F, I); } SEAM(0);
    if (SITE_ADA && IN(1)) { PH_IDS(F);
        pg8::Gemm g{(const pg8::bf16_t*)WSB(WS_SILC), (const pg8::bf16_t*)WSB(WS_WADA), 256, MODLD, D, D}; pg8::StaticOrder S; S.init(256, MODLD, F.G, (int)blockIdx.x);
        EpiMod E{(float*)WSB(WS_MOD), I.p[12]};
        pg8::gemm_phase<EpiMod, pg8::StaticOrder, GEMM_ALIGN, GEMM_SP2>(F.lds + RING_OFF, g, S, E, F.wave);
        { PH_IDS(F);
          constexpr int NCONV = P0_NITEMS - P0_ADA_ITEMS - P0_DEFER, NB = 4096, NA = NCONV - NB, NADA = MODLD / 256;
          const int bx = (int)blockIdx.x, nfree = F.G - NADA;
          if (nfree > 0) { if (bx >= NADA) p0_items(F, I, 0, NA, (bx - NADA) * NWAVES + F.wave, nfree * NWAVES); else p0_items(F, I, NA, NCONV, bx * NWAVES + F.wave, NADA * NWAVES); }
          else p0_items(F, I, 0, NCONV, F.gw, F.NGW); }
    } SEAM(1);

    for (int li = (PROBE_SITE == 20 ? -1 : 0); li < 4; ++li) {
        const int l = li < 0 ? 0 : li;
        const int base = 2 + 8 * l, hl = l >> 1;
        if (SITE_NORM && INL(0)) REP(2) { PH_IDS(F); norm_phase<false>(F, XSRC_P, XSRC_S, l == 0, I.p[9] + (size_t)(l * 2 + 0) * D, MODL + 0 * D, MODL + 1 * D, XN1p, nullptr, (const float*)WSB(WS_PART), (l == 0 || !USE_SPLITK) ? 0 : FF / 256, MODL - 6144 + 5 * D, Xp); }
        SEAM_WT(base + 0);
        if ((l & 1) == 0) {
            if (SITE_IN && INL(1)) REP(3) { PH_IDS(F);
                pg8::Gemm g{XN1p, (const pg8::bf16_t*)WSB(WS_WIN) + (size_t)hl * INC * D, M, INC, D, D}; pg8::StaticOrder S; S.init(M, INC, F.G, (int)blockIdx.x);
                EpiIn E{(bf16*)WSB(WS_U), (bf16*)WSB(WS_Q), (const float*)WSB(WS_ROPE), F.out, hl};
                pg8::gemm_phase<EpiIn, pg8::StaticOrder, GEMM_ALIGN, GEMM_SP2>(F.lds + RING_OFF, g, S, E, F.wave);
                if (l == 0 && PROBE_SITE != 3) {
                    PH_IDS(F);
                    constexpr int NU = (M / 256) * (INC / 256); const int nfull = NU % F.G, bx = (int)blockIdx.x;
                    constexpr int D0 = P0_NITEMS - P0_ADA_ITEMS - P0_DEFER, D1 = P0_NITEMS - P0_ADA_ITEMS;
                    if (nfull > 0 && nfull < F.G) { if (bx >= nfull) p0_items(F, I, D0, D1, (bx - nfull) * NWAVES + F.wave, (F.G - nfull) * NWAVES); }
                    else p0_items(F, I, D0, D1, F.gw, F.NGW);
                }
            } SEAM(base + 1);
            if (SITE_ATTN && INL(2)) REP(4) attn_phase_v2(F, I, hl);
            SEAM(base + 2);
            if (SITE_CONV && INL(3)) REP(5) { merge_rows(F); }
            SEAM_WT(base + 3);
            if (SITE_O && INL(4)) { PH_IDS(F);
                { pg8::Gemm g{(const pg8::bf16_t*)WSB(WS_MIX), (const pg8::bf16_t*)WSB(WS_WO) + (size_t)hl * D * MIXK, USE_SPLITK ? MP : M, D, MIXK, MIXK}; pg8::StaticOrder S; S.init(USE_SPLITK ? MP : M, D, F.G, (int)blockIdx.x);
                  EpiResid E{XSRC_P, XSRC_S, l == 0, Xp, MODL + 2 * D};
                  pg8::gemm_phase<EpiResid, pg8::StaticOrder, GEMM_ALIGN, GEMM_SP2>(F.lds + RING_OFF, g, S, E, F.wave); }
                if (USE_SPLITK) { PH_IDS(F);
                  pg8::Gemm g{(const pg8::bf16_t*)WSB(WS_MIX), (const pg8::bf16_t*)WSB(WS_WO) + (size_t)hl * D * MIXK, M, D, MIXK, 256}; pg8::SplitOrder S; S.init(MP / 256, MS / 256, D, MIXK / 256, 256, F.G, (int)blockIdx.x);
                  EpiPartial E{(float*)WSB(WS_PART2), D};
                  pg8::gemm_phase<EpiPartial, pg8::SplitOrder, GEMM_ALIGN, GEMM_SP2>(F.lds + RING_OFF, g, S, E, F.wave); }
            } SEAM(base + 4);
        } else {
#if S5_FUSED
            if (SITE_S5C && INL(1)) REP(7) s5_fused_phase_DISABLED(F, I, hl);
            SEAM1(base + 1, base + 4);
#else
            if (SITE_S5A && INL(1)) REP(6) s5_local_phase2(F, hl);
            SEAM1(base + 1, base + 3);
            if (SITE_S5C && INL(3)) REP(7) s5_out_phase2(F, I, hl);
            SEAM(base + 3);
#endif
            if (SITE_GLU && INL(4)) { PH_IDS(F);
                { pg8::Gemm g{(const pg8::bf16_t*)WSB(WS_ZZ), (const pg8::bf16_t*)WSB(WS_WGLU) + (size_t)hl * 2 * D * D, USE_SPLITK ? MP : M, 2 * D, D, D}; pg8::StaticOrder S; S.init(USE_SPLITK ? MP : M, 2 * D, F.G, (int)blockIdx.x);
                  EpiGLU E{Xp, MODL + 2 * D, I.p[28] + (size_t)hl * 2 * D};
                  pg8::gemm_phase<EpiGLU, pg8::StaticOrder, GEMM_ALIGN, GEMM_SP2>(F.lds + RING_OFF, g, S, E, F.wave); }
                if (USE_SPLITK) { PH_IDS(F);
                  pg8::Gemm g{(const pg8::bf16_t*)WSB(WS_ZZ), (const pg8::bf16_t*)WSB(WS_WGLU) + (size_t)hl * 2 * D * D, M, 2 * D, D, 256}; pg8::SplitOrder S; S.init(MP / 256, MS / 256, 2 * D, D / 256, 256, F.G, (int)blockIdx.x);
                  EpiPartial E{(float*)WSB(WS_PART2), 2 * D};
                  pg8::gemm_phase<EpiPartial, pg8::SplitOrder, GEMM_ALIGN, GEMM_SP2>(F.lds + RING_OFF, g, S, E, F.wave); }
            } SEAM(base + 4);
        }
        _Pragma("unroll 1") for (int rp_ = 0; rp_ < (PROBE_SITE == 21 ? 2 : 1); ++rp_) {
        if (SITE_NORM && INL(5)) REP(2) { PH_IDS(F); norm_phase<false>(F, Xp, ((l & 1) == 0 && USE_SPLITK) ? XSRC_S : (const void*)(Xp + (size_t)MP * D), (l == 0 && USE_SPLITK) ? 2 : 0, I.p[9] + (size_t)(l * 2 + 1) * D, MODL + 3 * D, MODL + 4 * D, XN2p, nullptr, (const float*)WSB(WS_PART2), !USE_SPLITK ? 0 : ((l & 1) == 0 ? MIXK / 256 : D / 256), MODL + 2 * D, Xp, (l & 1) ? I.p[28] + (size_t)hl * 2 * D : nullptr); }
        SEAM_WT(base + 5);
        if (SITE_UP && INL(6)) REP(8) { PH_IDS(F);
            pg8::Gemm g{XN2p, (const pg8::bf16_t*)WSB(WS_WGU) + (size_t)l * 2 * FF * D, M, 2 * FF, D, D}; pg8::StaticOrder S; S.init(M, 2 * FF, F.G, (int)blockIdx.x);
            EpiSwiGLU E{(bf16*)WSB(WS_ACT)};
            pg8::gemm_phase<EpiSwiGLU, pg8::StaticOrder, GEMM_ALIGN, GEMM_SP2>(F.lds + RING_OFF, g, S, E, F.wave);
        } SEAM(base + 6);
        }
        if (SITE_DOWN && INL(7)) { PH_IDS(F);
            { pg8::Gemm g{(const pg8::bf16_t*)WSB(WS_ACT), (const pg8::bf16_t*)WSB(WS_WD) + (size_t)l * D * FF, USE_SPLITK ? MP : M, D, FF, FF}; pg8::StaticOrder S; S.init(USE_SPLITK ? MP : M, D, F.G, (int)blockIdx.x);
              EpiResid E{Xp, Xp + (size_t)MP * D, 0, Xp, MODL + 5 * D};
              pg8::gemm_phase<EpiResid, pg8::StaticOrder, GEMM_ALIGN, GEMM_SP2>(F.lds + RING_OFF, g, S, E, F.wave); }
            if (USE_SPLITK) { PH_IDS(F);
              pg8::Gemm g{(const pg8::bf16_t*)WSB(WS_ACT), (const pg8::bf16_t*)WSB(WS_WD) + (size_t)l * D * FF, M, D, FF, 256}; pg8::SplitOrder S; S.init(MP / 256, MS / 256, D, FF / 256, 256, F.G, (int)blockIdx.x);
              EpiPartial E{(float*)WSB(WS_PART), D};
              pg8::gemm_phase<EpiPartial, pg8::SplitOrder, GEMM_ALIGN, GEMM_SP2>(F.lds + RING_OFF, g, S, E, F.wave); }
        } SEAM(base + 7);
    }
    if (SITE_FINAL && IN(34)) { PH_IDS(F); const int l = 4; norm_phase<true>(F, Xp, Xp + (size_t)MP * D, 0, I.p[10], nullptr, nullptr, nullptr, F.out + O_YP, (const float*)WSB(WS_PART), USE_SPLITK ? FF / 256 : 0, MODL - 6144 + 5 * D, Xp); }
#undef IN
#undef SEAM
}

extern "C" void kernel_launch(void* const* d_in, const int* in_sizes, int n_in, void* d_out, int out_size, void* d_ws, size_t ws_size, hipStream_t stream) {
    static int grid = 0;
    if (grid == 0) {
        if (n_in != 32 || in_sizes[0] != MP * D || (size_t)out_size != O_END || ws_size < WS_END2) { fprintf(stderr, "kernel_launch: unexpected shapes (n_in %d, in0 %d, out %d, ws %zu); nothing launched\n", n_in, n_in > 0 ? in_sizes[0] : -1, out_size, ws_size); grid = -1; return; }
        int dev = 0, cus = 0, per_cu = 0;
        if (hipGetDevice(&dev) != hipSuccess || hipDeviceGetAttribute(&cus, hipDeviceAttributeMultiprocessorCount, dev) != hipSuccess) { grid = -1; return; }
        if (hipFuncSetAttribute((const void*)trunk_fwd, hipFuncAttributeMaxDynamicSharedMemorySize, LDS_BYTES) != hipSuccess) { fprintf(stderr, "kernel_launch: hipFuncSetAttribute failed\n"); grid = -1; return; }
        if (hipOccupancyMaxActiveBlocksPerMultiprocessor(&per_cu, (const void*)trunk_fwd, NWAVES * 64, LDS_BYTES) != hipSuccess || per_cu < 1) fprintf(stderr, "kernel_launch: occupancy query reports %d\n", per_cu);
        (void)hipGetLastError();
        grid = cus;
    }
    if (grid < 0) return;
    if (hipMemsetAsync((char*)d_ws + WS_CTL, 0, CTL_ZERO_BYTES, stream) != hipSuccess) return;
    Args a{};
    for (int i = 0; i < 32; ++i) a.in.p[i] = (const float*)d_in[i];
    a.out = (float*)d_out; a.ws = (unsigned char*)d_ws;
#if MK_PER_PHASE
    for (int k = 0; k < NPHASES; ++k) { a.ph_lo = k; a.ph_hi = k + 1; hipLaunchKernelGGL(trunk_fwd, dim3(grid), dim3(NWAVES * 64), LDS_BYTES, stream, a); }
#else
    a.ph_lo = 0; a.ph_hi = NPHASES;
    hipLaunchKernelGGL(trunk_fwd, dim3(grid), dim3(NWAVES * 64), LDS_BYTES, stream, a);
#endif
}
```

```cpp
#include <hip/hip_runtime.h>
#include <cstdio>
#include <cstdint>
#define MK_PER_PHASE 0
namespace pg8 {
#define PG8_LAS __attribute__((address_space(3)))
typedef unsigned short bf16_t;
typedef short bf16x8 __attribute__((ext_vector_type(8)));
typedef float f32x4 __attribute__((ext_vector_type(4)));
typedef unsigned u32x4 __attribute__((ext_vector_type(4)));
constexpr int BM = 256, BK = 64, HALF = 128, HTB = HALF * BK * 2  , STAGE_BYTES = 8 * HTB, NXCD = 8, WGM = 8;

__host__ __device__ __forceinline__ int lds_byte(int r, int c) { const int st = (r >> 4) * 2 + (c >> 5), rr = r & 15, cc = c & 31, ob = rr * 64 + cc * 2; return st * 1024 + (ob ^ (((ob >> 9) & 1) << 5)); }
__host__ __device__ __forceinline__ void stage_rc(int b, int& R, int& C) { const int st = b / 1024, sb = b % 1024, swz = sb ^ (((sb >> 9) & 1) << 5); R = (st >> 1) * 16 + swz / 64; C = (st & 1) * 32 + (swz % 64) / 2; }
__host__ __device__ __forceinline__ int perm32(int rho) { const int n = rho >> 4, i = rho & 15; return 8 * (i >> 2) + 4 * n + (i & 3); }

__device__ __forceinline__ int lane_id_v() { int l; asm volatile("v_mbcnt_lo_u32_b32 %0, -1, 0\n\tv_mbcnt_hi_u32_b32 %0, -1, %0" : "=v"(l)); return l; }
struct Unit { int pm, pn, kb, sl; };
struct Gemm { const bf16_t* A; const bf16_t* Bt; int M, N, K, Kl; };

struct StaticOrder {
    int nM, nN, nwg, G, c;
    __host__ __device__ void init(int M, int N, int G_, int c_) { nM = M / BM; nN = N / BM; nwg = nM * nN; G = G_; c = c_; }
    __host__ __device__ bool next(int i, Unit& u) const {
        const long L = (long)i * G + c; if (L >= nwg) return false;
        int wgid = (int)L; { const int q = nwg / NXCD, r = nwg % NXCD, xcd = wgid % NXCD, off = wgid / NXCD; wgid = (xcd < r ? xcd * (q + 1) : r * (q + 1) + (xcd - r) * q) + off; }
        const int nig = WGM * nN, gid = wgid / nig, fm = gid * WGM, gsz = (nM - fm) < WGM ? (nM - fm) : WGM;
        u.pm = fm + ((wgid % nig) % gsz); u.pn = (wgid % nig) / gsz; u.kb = 0; u.sl = 0; return true;
    }
    __device__ __forceinline__ void a_ready(const Unit&) const {}
    __device__ __forceinline__ void done(const Unit&) const {}
};
struct SplitOrder {
    int pm0, npm, nN, nS, G, c, Kl;
    __host__ __device__ void init(int pm0_, int npm_, int N, int nS_, int Kl_, int G_, int c_) { pm0 = pm0_; npm = npm_; nN = N / BM; nS = nS_; Kl = Kl_; G = G_; c = c_; }
    __host__ __device__ bool next(int i, Unit& u) const {
        const int L = i * G + c; if (L >= npm * nN * nS) return false;
        u.sl = L % nS; const int r = L / nS; u.pn = r % nN; u.pm = pm0 + r / nN; u.kb = u.sl * Kl * 2; return true;
    }
    __device__ __forceinline__ void a_ready(const Unit&) const {}
    __device__ __forceinline__ void done(const Unit&) const {}
};


__device__ __forceinline__ unsigned cvt_pk_bf16(float lo, float hi) { unsigned r; asm volatile("v_cvt_pk_bf16_f32 %0, %1, %2" : "=v"(r) : "v"(lo), "v"(hi)); return r; }
typedef float f32x2 __attribute__((ext_vector_type(2)));
__device__ __forceinline__ f32x2 gelu_pk(f32x2 v) {
    const f32x2 av = __builtin_elementwise_abs(v), d = av * 0.2316418882f + 1.0f;
    f32x2 t; t.x = __builtin_amdgcn_rcpf(d.x); t.y = __builtin_amdgcn_rcpf(d.y);
    f32x2 q = t * 0.5307027145f + (-0.7265760135f); q = q * t + 0.7107068705f; q = q * t + (-0.142248368f); q = q * t + 0.127414796f; q = q * t;
    const f32x2 s = (v * v) * (-0.72134752044f);
    f32x2 e; e.x = __builtin_amdgcn_exp2f(s.x); e.y = __builtin_amdgcn_exp2f(s.y);
    const f32x2 m = v * (q * e), r = v - m;
    f32x2 o; o.x = v.x < 0.f ? m.x : r.x; o.y = v.y < 0.f ? m.y : r.y; return o;
}

template <int ACT  > struct EpiBf16 {
    static constexpr bool PERM = true, AFTER_DRAIN = false; static_assert(ACT == 0 || ACT == 1, "EpiBf16: ACT is 0 (none) or 1 (gelu_pk)");
    bf16_t* O; int ldc; const float* bias; int split_cols; size_t split_stride; float scale0;
    __device__ __forceinline__ void operator()(const f32x4 (&acc)[2][2][4][2], const Unit& u, int wr, int wc, int fr, int fq) const {
        const int row0 = u.pm * BM + wr * 64 + fr; int colt = u.pn * BM; bf16_t* base = O;
        float sc = 1.f; if (split_cols) { const int t = colt / split_cols; base += (size_t)t * split_stride; colt -= t * split_cols; if (t == 0) sc = scale0; }
        const int col0 = colt + wc * 32 + 8 * fq, bcol0 = u.pn * BM + wc * 32 + 8 * fq;
        f32x4 bv[2][2];
#pragma unroll
        for (int bj = 0; bj < 2; ++bj)
#pragma unroll
            for (int n = 0; n < 2; ++n) bv[bj][n] = bias ? *(const f32x4*)(bias + bcol0 + bj * HALF + 4 * n) : (f32x4){0.f, 0.f, 0.f, 0.f};
#pragma unroll
        for (int ai = 0; ai < 2; ++ai)
#pragma unroll
            for (int m = 0; m < 4; ++m) { bf16_t* rowp = base + (size_t)(row0 + ai * HALF + m * 16) * ldc + col0;
#pragma unroll
                for (int bj = 0; bj < 2; ++bj) { f32x4 v0 = acc[ai][bj][m][0] + bv[bj][0], v1 = acc[ai][bj][m][1] + bv[bj][1];
                    if (ACT == 1) { f32x2 a = gelu_pk((f32x2){v0[0], v0[1]}), b = gelu_pk((f32x2){v0[2], v0[3]}), c = gelu_pk((f32x2){v1[0], v1[1]}), d = gelu_pk((f32x2){v1[2], v1[3]});
                        v0 = (f32x4){a.x, a.y, b.x, b.y}; v1 = (f32x4){c.x, c.y, d.x, d.y}; }
                    v0 = v0 * sc; v1 = v1 * sc; u32x4 w; w.x = cvt_pk_bf16(v0[0], v0[1]); w.y = cvt_pk_bf16(v0[2], v0[3]); w.z = cvt_pk_bf16(v1[0], v1[1]); w.w = cvt_pk_bf16(v1[2], v1[3]);
                    *(u32x4*)(rowp + bj * HALF) = w; } }
    }
};

template <class Epi, class Sched, bool ALIGN_EPI = false, bool SP2 = false>
__device__ __forceinline__ void gemm_phase(PG8_LAS unsigned char* lds, const Gemm g, const Sched& S, const Epi& E, int wave_in) {
    const int lane = lane_id_v(), wid = wave_in, tid = wid * 64 + lane, wr = wid >> 2, wc = wid & 3, fr = lane & 15, fq = lane >> 4;
    const int K = g.K, nt = g.Kl / BK;
    unsigned voffA[2], voffB[2];
#pragma unroll
    for (int i = 0; i < 2; ++i) { int R, C; stage_rc(tid * 16 + i * 8192, R, C); const int Rb = Epi::PERM ? ((R & ~31) + perm32(R & 31)) : R;
        voffA[i] = (unsigned)(R * K + C) * 2u; voffB[i] = (unsigned)(Rb * K + C) * 2u; }
    const size_t kstep = (size_t)(BK * 2);
    const size_t hstep = (size_t)HALF * K * 2;
    const size_t tstep = 2 * hstep;
    const unsigned ldsw = (unsigned)wid * 1024u;
    const int aoff = lds_byte(wr * 64 + fr, fq * 8), boff = lds_byte(wc * 32 + fr, fq * 8);
#define PG8_SA(b, h) (((b) * 2 + (h)) * HTB)
#define PG8_SB(b, h) ((4 + (b) * 2 + (h)) * HTB)
#define PG8_STAGE(bufoff, gbase, voff) do { _Pragma("unroll") for (int _i = 0; _i < 2; ++_i) \
        __builtin_amdgcn_global_load_lds((const unsigned*)((const char*)(gbase) + (voff)[_i]), (PG8_LAS unsigned*)(lds + (bufoff) + ldsw + _i * 8192), 16, 0, 0); } while (0)
#define PG8_LDA(dst, b, h) do { _Pragma("unroll") for (int m = 0; m < 4; ++m) _Pragma("unroll") for (int k = 0; k < 2; ++k) dst[m][k] = *(const PG8_LAS bf16x8*)(lds + PG8_SA(b, h) + aoff + m * 2048 + k * 1024); } while (0)
#define PG8_LDB(dst, b, h) do { _Pragma("unroll") for (int n = 0; n < 2; ++n) _Pragma("unroll") for (int k = 0; k < 2; ++k) dst[n][k] = *(const PG8_LAS bf16x8*)(lds + PG8_SB(b, h) + boff + n * 2048 + k * 1024); } while (0)
#define PG8_MMA(ai, bj, At, Bt) do { __builtin_amdgcn_s_setprio(1); _Pragma("unroll") for (int m = 0; m < 4; ++m) _Pragma("unroll") for (int n = 0; n < 2; ++n) _Pragma("unroll") for (int k = 0; k < 2; ++k) \
        acc[ai][bj][m][n] = __builtin_amdgcn_mfma_f32_16x16x32_bf16(Bt[n][k], At[m][k], acc[ai][bj][m][n], 0, 0, 0); __builtin_amdgcn_s_setprio(0); } while (0)
#define PG8_WAIT_V(n) asm volatile("s_waitcnt vmcnt(" #n ")" ::: "memory")
#define PG8_WAIT_L(n) asm volatile("s_waitcnt lgkmcnt(" #n ")" ::: "memory")
#define PG8_BAR __builtin_amdgcn_s_barrier()
#define PG8_SCHED __builtin_amdgcn_sched_barrier(0)
    Unit cur, nxt; int ui = 0;
    if (!S.next(0, cur)) return;
    f32x4 acc[2][2][4][2];
#pragma unroll
    for (int a = 0; a < 2; ++a)
#pragma unroll
        for (int b = 0; b < 2; ++b)
#pragma unroll
            for (int m = 0; m < 4; ++m)
#pragma unroll
                for (int n = 0; n < 2; ++n) acc[a][b][m][n] = (f32x4){0.f, 0.f, 0.f, 0.f};
    bf16x8 At[4][2], B0[2][2], B1[2][2];
    const char* cA = (const char*)g.A + (size_t)cur.pm * tstep + cur.kb; const char* cB = (const char*)g.Bt + (size_t)cur.pn * tstep + cur.kb;
    S.a_ready(cur);
    if constexpr (SP2) {
        PG8_STAGE(PG8_SB(0, 0), cB, voffB); PG8_STAGE(PG8_SB(0, 1), cB + hstep, voffB); PG8_STAGE(PG8_SA(0, 0), cA, voffA); PG8_STAGE(PG8_SA(0, 1), cA + hstep, voffA);
        if (wr == 1) PG8_BAR;
        PG8_WAIT_V(2); PG8_BAR;
        PG8_STAGE(PG8_SB(1, 0), cB + kstep, voffB); PG8_STAGE(PG8_SA(1, 0), cA + kstep, voffA); PG8_STAGE(PG8_SB(1, 1), cB + hstep + kstep, voffB);
        PG8_WAIT_V(6); PG8_BAR;
    } else {
        PG8_STAGE(PG8_SB(0, 0), cB, voffB); PG8_STAGE(PG8_SA(0, 0), cA, voffA); PG8_STAGE(PG8_SB(0, 1), cB + hstep, voffB); PG8_STAGE(PG8_SA(0, 1), cA + hstep, voffA);
        if (wr == 1) PG8_BAR;
        PG8_WAIT_V(4); PG8_BAR;
        PG8_STAGE(PG8_SB(1, 0), cB + kstep, voffB); PG8_STAGE(PG8_SA(1, 0), cA + kstep, voffA); PG8_STAGE(PG8_SB(1, 1), cB + hstep + kstep, voffB);
        PG8_WAIT_V(6); PG8_BAR;
    }
    for (;;) {
        const bool has_next = S.next(ui + 1, nxt);
        const char* nA = has_next ? (const char*)g.A + (size_t)nxt.pm * tstep + nxt.kb : cA; const char* nB = has_next ? (const char*)g.Bt + (size_t)nxt.pn * tstep + nxt.kb : cB;
        for (int t = 0; t < nt; t += 2) {
            const bool last = (t == nt - 2);
            const char* a1 = cA + (size_t)(t + 1) * kstep;
            const char* a2 = last ? nA : cA + (size_t)(t + 2) * kstep; const char* b2 = last ? nB : cB + (size_t)(t + 2) * kstep;
            const char* a3 = a2 + kstep; const char* b3 = b2 + kstep;
            if (last && has_next) S.a_ready(nxt);
            if constexpr (SP2) {
            PG8_LDB(B0, 0, 0); PG8_LDB(B1, 0, 1); PG8_SCHED; PG8_LDA(At, 0, 0); PG8_STAGE(PG8_SA(1, 1), a1 + hstep, voffA);
            PG8_WAIT_V(8); PG8_WAIT_L(0); PG8_BAR; PG8_MMA(0, 0, At, B0); PG8_MMA(0, 1, At, B1); PG8_BAR; PG8_SCHED;
            PG8_LDA(At, 0, 1); PG8_STAGE(PG8_SB(0, 0), b2, voffB); PG8_STAGE(PG8_SB(0, 1), b2 + hstep, voffB); PG8_STAGE(PG8_SA(0, 0), a2, voffA);
            PG8_WAIT_V(8); PG8_WAIT_L(0); PG8_BAR; PG8_MMA(1, 0, At, B0); PG8_MMA(1, 1, At, B1); PG8_BAR; PG8_SCHED;
            PG8_LDB(B0, 1, 0); PG8_LDB(B1, 1, 1); PG8_SCHED; PG8_LDA(At, 1, 0); PG8_STAGE(PG8_SA(0, 1), a2 + hstep, voffA);
            PG8_WAIT_V(8); PG8_WAIT_L(0); PG8_BAR; PG8_MMA(0, 0, At, B0); PG8_MMA(0, 1, At, B1); PG8_BAR; PG8_SCHED;
            PG8_LDA(At, 1, 1); PG8_STAGE(PG8_SB(1, 0), b3, voffB); PG8_STAGE(PG8_SB(1, 1), b3 + hstep, voffB); PG8_STAGE(PG8_SA(1, 0), a3, voffA);
            PG8_WAIT_V(8); PG8_WAIT_L(0); PG8_BAR; PG8_MMA(1, 0, At, B0); PG8_MMA(1, 1, At, B1); PG8_BAR; PG8_SCHED;
            } else {
            PG8_LDB(B0, 0, 0); PG8_SCHED; PG8_LDA(At, 0, 0); PG8_STAGE(PG8_SA(1, 1), a1 + hstep, voffA);
            PG8_WAIT_L(8); PG8_BAR; PG8_WAIT_L(0); PG8_MMA(0, 0, At, B0); PG8_BAR; PG8_SCHED;
            PG8_LDB(B1, 0, 1); PG8_STAGE(PG8_SB(0, 0), b2, voffB);
            PG8_BAR; PG8_WAIT_L(0); PG8_MMA(0, 1, At, B1); PG8_BAR;
            PG8_LDA(At, 0, 1); PG8_STAGE(PG8_SA(0, 0), a2, voffA);
            PG8_BAR; PG8_WAIT_L(0); PG8_MMA(1, 0, At, B0); PG8_BAR; PG8_SCHED;
            PG8_STAGE(PG8_SB(0, 1), b2 + hstep, voffB);
            PG8_WAIT_V(6); PG8_BAR; PG8_MMA(1, 1, At, B1); PG8_BAR;
            PG8_LDB(B0, 1, 0); PG8_SCHED; PG8_LDA(At, 1, 0); PG8_STAGE(PG8_SA(0, 1), a2 + hstep, voffA);
            PG8_WAIT_L(8); PG8_BAR; PG8_WAIT_L(0); PG8_MMA(0, 0, At, B0); PG8_BAR; PG8_SCHED;
            PG8_LDB(B1, 1, 1); PG8_STAGE(PG8_SB(1, 0), b3, voffB);
            PG8_BAR; PG8_WAIT_L(0); PG8_MMA(0, 1, At, B1); PG8_BAR;
            PG8_LDA(At, 1, 1); PG8_STAGE(PG8_SA(1, 0), a3, voffA);
            PG8_BAR; PG8_WAIT_L(0); PG8_MMA(1, 0, At, B0); PG8_BAR; PG8_SCHED;
            PG8_STAGE(PG8_SB(1, 1), b3 + hstep, voffB);
            PG8_WAIT_V(6); PG8_BAR; PG8_MMA(1, 1, At, B1); PG8_BAR;
            }
        }
        if constexpr (ALIGN_EPI) { if (wr == 0) PG8_BAR; }
        if constexpr (!Epi::AFTER_DRAIN) { E(acc, cur, wr, wc, fr, fq); S.done(cur); }
        if (!has_next) break;
#pragma unroll
        for (int a = 0; a < 2; ++a)
#pragma unroll
            for (int b = 0; b < 2; ++b)
#pragma unroll
                for (int m = 0; m < 4; ++m)
#pragma unroll
                    for (int n = 0; n < 2; ++n) acc[a][b][m][n] = (f32x4){0.f, 0.f, 0.f, 0.f};
        cur = nxt; cA = nA; cB = nB; ++ui;
        if constexpr (ALIGN_EPI) { if (wr == 1) PG8_BAR; }
    }
    PG8_WAIT_V(0);
    if constexpr (!ALIGN_EPI) { if (wr == 0) PG8_BAR; }
    PG8_BAR;
    if constexpr (Epi::AFTER_DRAIN) { E.fused(acc, cur, wr, wc, fr, fq, lds, wid, lane); S.done(cur); }
#undef PG8_SA
#undef PG8_SB
#undef PG8_STAGE
#undef PG8_LDA
#undef PG8_LDB
#undef PG8_MMA
#undef PG8_WAIT_V
#undef PG8_WAIT_L
#undef PG8_BAR
#undef PG8_SCHED
}
}

constexpr int D = 1024, MP = 16384, MS = 1024, M = MP + MS, SEQ = 4096, NB_P = 4, NB_S = 128, TS = 8, NBT = NB_P + NB_S;
constexpr int FF = 2816, INC = 3328, MIXK = 768, ATW = 768, CCH = 512, MODLD = 4 * 6144;
constexpr float EPS = 1e-6f;
constexpr float QSCALE = 0.125f * 1.4426950408889634f;
constexpr size_t O_YP = 0, O_YS = O_YP + (size_t)MP * D, O_CONVP = O_YS + (size_t)MS * D, O_KV0P = O_CONVP + 2ull * 4 * 30 * 512,
    O_KV1P = O_KV0P + 2ull * 4 * 128 * 512, O_KV2P = O_KV1P + 2ull * 4 * 512 * 512, O_S5P = O_KV2P + 2ull * 4 * 2048 * 512,
    O_CONVS = O_S5P + 2ull * 4 * 64 * 64 * 2, O_KV0S = O_CONVS + 2ull * 128 * 30 * 512, O_KV1S = O_KV0S + 2ull * 128 * 8 * 512,
    O_KV2S = O_KV1S + 2ull * 128 * 8 * 512, O_S5S = O_KV2S + 2ull * 128 * 8 * 512, O_END = O_S5S + 2ull * 128 * 64 * 64 * 2;
static_assert(O_END == 38199296ull, "output size");

constexpr size_t MiB = 1u << 20;
constexpr size_t WS_CTL = 0, CTL_ZERO_BYTES = 64 * 1024;
constexpr size_t WS_WIN = 1 * MiB;
constexpr size_t WS_WO = WS_WIN + 14 * MiB;
constexpr size_t WS_WGLU = WS_WO + 3 * MiB;
constexpr size_t WS_WGU = WS_WGLU + 8 * MiB;
constexpr size_t WS_WD = WS_WGU + 44 * MiB;
constexpr size_t WS_WADA = WS_WD + 22 * MiB;
constexpr size_t WS_SILC = WS_WADA + 48 * MiB;
constexpr size_t WS_MOD = WS_SILC + 1 * MiB;
constexpr size_t WS_ROPE = WS_MOD + 13 * MiB;
constexpr size_t WS_S5AB = WS_ROPE + 1 * MiB;
constexpr size_t WS_S5ABT = WS_S5AB + 64 * 1024;
constexpr size_t WS_S5BB = WS_S5ABT + 64 * 1024;
constexpr size_t WS_X = WS_S5BB + 1 * MiB;
constexpr size_t WS_XN = WS_X + 68 * MiB;
constexpr size_t WS_Q = WS_XN + 34 * MiB;
constexpr size_t WS_K = WS_Q + 26 * MiB;
constexpr size_t WS_V = WS_K + 26 * MiB;
constexpr size_t WS_U = WS_V + 26 * MiB;
constexpr size_t WS_MIX = WS_U + 17 * MiB;
constexpr size_t WS_OG = WS_MIX + 26 * MiB;
constexpr size_t WS_LSE = WS_OG + 51 * MiB;
constexpr size_t WS_ACT = WS_LSE + 1 * MiB;
constexpr size_t WS_ZZ = WS_ACT + 94 * MiB;
constexpr size_t WS_S5E = WS_ZZ + 34 * MiB;
constexpr size_t WS_S5SIN = WS_S5E + 4 * MiB;
constexpr size_t WS_END = WS_S5SIN + 4 * MiB;
static_assert((size_t)M * D * 4 <= 68 * MiB && (size_t)M * 768 * 2 <= 26 * MiB && (size_t)M * FF * 2 <= 94 * MiB && 3ull * M * 256 * 4 <= 51 * MiB && 132ull * MODLD * 4 <= 13 * MiB, "ws map");

static_assert(WS_K - WS_Q == WS_V - WS_K && O_KV1P == O_KV0P + 4096ull * 128 && O_KV2P == O_KV0P + 4096ull * 640 && O_KV2S - O_KV1S == O_KV1S - O_KV0S, "arithmetic buffer selection");
constexpr int CW_TMO = 0, CW_BAR = 4096;
constexpr int NWAVES = 8;
constexpr int RING_OFF = 0, RING_BYTES = 131072;
constexpr int LDSCTL_OFF = RING_BYTES, MISC_OFF = LDSCTL_OFF + 320;
constexpr int LDS_BYTES = 147456;

#define GAS __attribute__((address_space(1)))
#define LAS __attribute__((address_space(3)))
typedef unsigned short bf16;
typedef unsigned v4u __attribute__((ext_vector_type(4)));
typedef unsigned v2u __attribute__((ext_vector_type(2)));
typedef float f32x4 __attribute__((ext_vector_type(4)));
typedef float f32x2 __attribute__((ext_vector_type(2)));
typedef GAS unsigned gu32;
#define RLX_AGENT __ATOMIC_RELAXED, __HIP_MEMORY_SCOPE_AGENT
#define LDS_WAIT() asm volatile("s_waitcnt lgkmcnt(0)" ::: "memory")
#define VM_WAIT() asm volatile("s_waitcnt vmcnt(0)" ::: "memory")
#define DI __device__ __forceinline__
DI unsigned f2bf(float f) { unsigned u = __builtin_bit_cast(unsigned, f); return (u + 0x7fffu + ((u >> 16) & 1u)) >> 16; }
DI unsigned pk2(float lo, float hi) { return f2bf(lo) | (f2bf(hi) << 16); }
DI float bf2f(unsigned h) { return __builtin_bit_cast(float, h << 16); }
DI float bflo(unsigned w) { return __builtin_bit_cast(float, w << 16); }
DI float bfhi(unsigned w) { return __builtin_bit_cast(float, w & 0xffff0000u); }
DI float fast_exp2(float x) { return __builtin_amdgcn_exp2f(x); }
DI float fast_exp(float x) { return __builtin_amdgcn_exp2f(x * 1.4426950408889634f); }
DI float fast_log2(float x) { return __builtin_amdgcn_logf(x); }
DI float fast_rcp(float x) { return __builtin_amdgcn_rcpf(x); }
DI float sigmoidf_(float x) { return fast_rcp(1.f + fast_exp(-x)); }
DI float gelu_tanh(float x) { const float z = 0.7978845608028654f * (x + 0.044715f * x * x * x); const float e = fast_exp(2.f * z); const float th = 1.f - 2.f * fast_rcp(e + 1.f); return 0.5f * x * (1.f + th); }
template <class T> DI T* uni_ptr(T* p) { const unsigned long long v = (unsigned long long)p; const unsigned lo = __builtin_amdgcn_readfirstlane((unsigned)v), hi = __builtin_amdgcn_readfirstlane((unsigned)(v >> 32)); return (T*)(GAS T*)(((unsigned long long)hi << 32) | lo); }
template <class T> DI T* opaque_uniform(T* p) { const unsigned long long v = (unsigned long long)p; unsigned lo = __builtin_amdgcn_readfirstlane((unsigned)v), hi = __builtin_amdgcn_readfirstlane((unsigned)(v >> 32)); asm volatile("" : "+s"(lo), "+s"(hi)); return (T*)(GAS T*)(((unsigned long long)hi << 32) | lo); }
constexpr size_t LSE_P = (size_t)3 * NB_P * 4 * SEQ;
DI size_t lse_idx_p(int g, int n, int h, int t) { const int sh = 2 * g, r = t & ((1 << sh) - 1), i = t >> sh; return ((size_t)((g * NB_P + n) * 4 + h) << 12) + ((size_t)r << (12 - sh)) + i; }
DI size_t lse_idx_s(int g, int srow, int h) { return LSE_P + ((size_t)g * MS + srow) * 4 + h; }
DI int row_batch(int r) { return r < MP ? (r >> 12) : NB_P + ((r - MP) >> 3); }
template <int K> DI float shx(float v) { return __builtin_bit_cast(float, __builtin_amdgcn_ds_swizzle(__builtin_bit_cast(int, v), (K << 10) | 0x1F)); }
DI void swap32(float v, float& a, float& b) { a = v; b = v; asm volatile("s_nop 1\n\tv_permlane32_swap_b32 %0, %1" : "+v"(a), "+v"(b)); }
DI float sum32(float v) { float a, b; swap32(v, a, b); return a + b; }
DI float max32(float v) { float a, b; swap32(v, a, b); return fmaxf(a, b); }
DI void st8_wt(void* p, unsigned lo, unsigned hi) { __hip_atomic_store((unsigned long long*)p, ((unsigned long long)hi << 32) | lo, __ATOMIC_RELAXED, __HIP_MEMORY_SCOPE_AGENT); }
DI float wave_sum(float v) { v += shx<1>(v); v += shx<2>(v); v += shx<4>(v); v += shx<8>(v); v += shx<16>(v); return sum32(v); }
#define XB_TMO      128
#define XB_XCNT(j)  (256  + 64 * (j))
#define XB_XSUB(j)  (1280 + 64 * (j))
#define XB_XGEN(j)  (2304 + 64 * (j))
#define XB_TOP      3328
#define XB_TOPGEN   3392
#define XCD_BAR_WORDS 3456
#define XB_SPIN_CAP (1u << 18)

__device__ __forceinline__ unsigned xb_ld(unsigned* p)              { return __hip_atomic_load(p, __ATOMIC_RELAXED, __HIP_MEMORY_SCOPE_AGENT); }
__device__ __forceinline__ unsigned xb_add(unsigned* p, unsigned v) { return __hip_atomic_fetch_add(p, v, __ATOMIC_RELAXED, __HIP_MEMORY_SCOPE_AGENT); }
__device__ __forceinline__ unsigned xb_xcc_id() { return (unsigned)__builtin_amdgcn_s_getreg((3 << 11) | 20) & 0xFu; }
#define XB_SPIN(cond, bar) do { unsigned _sp = 0; while (cond) { __builtin_amdgcn_s_sleep(1); \
    if ((++_sp & 255u) == 0u) { if (xb_ld(&(bar)[XB_TMO])) break; if (_sp > XB_SPIN_CAP) { atomicAdd(&(bar)[XB_TMO], 1u); break; } } } } while (0)

struct XcdBarrier {
    unsigned* bar; unsigned x;
    volatile LAS unsigned* st;
};

__device__ __forceinline__ XcdBarrier xcd_barrier_post(unsigned* bar, volatile LAS unsigned* st) {
    XcdBarrier b; b.bar = bar; b.x = xb_xcc_id(); b.st = st;
    if (threadIdx.x == 0) (void)xb_add(&bar[XB_XCNT(b.x)], 1u);
    return b;
}
__device__ __forceinline__ void xcd_barrier_complete(unsigned* bar, unsigned x, unsigned& nloc, unsigned& nx) {
    const unsigned G = gridDim.x * gridDim.y * gridDim.z;
    unsigned sum, cnt, mine, sp = 0u;
    for (;;) {
        sum = 0u; cnt = 0u; mine = 0u;
#pragma unroll
        for (unsigned j = 0; j < 16; ++j) { const unsigned c = xb_ld(&bar[XB_XCNT(j)]); sum += c; cnt += (c > 0u) ? 1u : 0u; mine = (j == x) ? c : mine; }
        if (sum == G) break;
        __builtin_amdgcn_s_sleep(1);
        if ((++sp & 255u) == 0u) { if (xb_ld(&bar[XB_TMO])) break; if (sp > XB_SPIN_CAP) { atomicAdd(&bar[XB_TMO], 1u); break; } }
    }
    nloc = mine > 0u ? mine : 1u; nx = cnt > 0u ? cnt : 1u;
}

__device__ __forceinline__ void xcd_barrier(const XcdBarrier& b, bool settle = false, bool wb = true) {
    asm volatile("s_waitcnt vmcnt(0)" ::: "memory");
    __syncthreads();
    if (threadIdx.x == 0) {
        unsigned* bar = b.bar;
        __builtin_amdgcn_s_waitcnt(0);
        unsigned nloc = b.st[0], nx = b.st[1];
        if (nloc == 0u) { xcd_barrier_complete(bar, b.x, nloc, nx); b.st[0] = nloc; b.st[1] = nx; }
        const unsigned old = xb_add(&bar[XB_XSUB(b.x)], 1u);
        const unsigned gen = old / nloc;
        if (old + 1u == (gen + 1u) * nloc) {
            if (wb) {
            __builtin_amdgcn_fence(__ATOMIC_RELEASE, "agent");
            asm volatile("s_waitcnt vmcnt(0)" ::: "memory");
            }
            asm volatile("buffer_inv sc1" ::: "memory");
            const unsigned og = xb_add(&bar[XB_TOP], 1u);
            const unsigned tg = og / nx;
            if (og + 1u == (tg + 1u) * nx) xb_add(&bar[XB_TOPGEN], 1u);
            else XB_SPIN(xb_ld(&bar[XB_TOPGEN]) == tg, bar);
            if (settle) __builtin_amdgcn_s_sleep(64);
            xb_add(&bar[XB_XGEN(b.x)], 1u);
            asm volatile("s_waitcnt vmcnt(0)" ::: "memory");
        } else {
            asm volatile("buffer_inv sc1" ::: "memory");
            XB_SPIN(xb_ld(&bar[XB_XGEN(b.x)]) == gen, bar);
            if (settle) __builtin_amdgcn_s_sleep(64);
            asm volatile("s_waitcnt vmcnt(0)" ::: "memory");
        }
        __builtin_amdgcn_fence(__ATOMIC_ACQUIRE, "workgroup");
    }
    __syncthreads();
}

#ifndef PROBE_SITE
#define PROBE_SITE 0
#endif
using pg8::Unit;
#ifndef WT_STORES
#define WT_STORES 0
#endif
DI void st16_wt(void* p, v4u v) {
#if WT_STORES
    asm volatile("global_store_dwordx4 %0, %1, off sc1\n\ts_nop 1" :: "v"(p), "v"(v) : "memory");
#else
    *(v4u*)p = v;
#endif
}
DI v4u pack8(const f32x4 a, const f32x4 b) { v4u w; w.x = pg8::cvt_pk_bf16(a[0], a[1]); w.y = pg8::cvt_pk_bf16(a[2], a[3]); w.z = pg8::cvt_pk_bf16(b[0], b[1]); w.w = pg8::cvt_pk_bf16(b[2], b[3]); return w; }

struct EpiMod {
    static constexpr bool PERM = false, AFTER_DRAIN = false;
    float* mod; const float* bias;
    DI void operator()(const f32x4 (&acc)[2][2][4][2], const Unit& u, int wr, int wc, int fr_, int fq_) const {
        const int ln_ = pg8::lane_id_v(), fr = ln_ & 15, fq = ln_ >> 4; (void)fr_; (void)fq_;
        const int col0 = u.pn * 256 + wc * 32 + 4 * fq;
#pragma unroll
        for (int ai = 0; ai < 2; ++ai)
#pragma unroll
            for (int m = 0; m < 4; ++m) { const int r = ai * 128 + wr * 64 + m * 16 + fr;
                if (r < NBT) {
#pragma unroll
                    for (int bj = 0; bj < 2; ++bj)
#pragma unroll
                        for (int n = 0; n < 2; ++n) { const int c = col0 + bj * 128 + n * 16; const f32x4 b = *(const f32x4*)(bias + c); *(f32x4*)(mod + (size_t)r * MODLD + c) = acc[ai][bj][m][n] + b; }
                } }
    }
};

DI void ldx8(const void* base, int is_f32, size_t elem, f32x4& a, f32x4& b) {
    if (is_f32) { const float* p = (const float*)base + elem; a = *(const f32x4*)p; b = *(const f32x4*)(p + 4); }
    else { const v4u w = *(const v4u*)((const bf16*)base + elem); a = (f32x4){bflo(w.x), bfhi(w.x), bflo(w.y), bfhi(w.y)}; b = (f32x4){bflo(w.z), bfhi(w.z), bflo(w.w), bfhi(w.w)}; }
}
struct EpiResid {
    static constexpr bool PERM = true, AFTER_DRAIN = false;
    const void* bp; const void* bs; int bf32; bf16* xo; const float* gate;
    DI void operator()(const f32x4 (&acc)[2][2][4][2], const Unit& u, int wr, int wc, int fr_, int fq_) const {
        const int ln_ = pg8::lane_id_v(), fr = ln_ & 15, fq = ln_ >> 4; (void)fr_; (void)fq_;
        const int col0 = u.pn * 256 + wc * 32 + 8 * fq;
#pragma unroll
        for (int ai = 0; ai < 2; ++ai)
#pragma unroll
            for (int m = 0; m < 4; ++m) { const int r = u.pm * 256 + ai * 128 + wr * 64 + m * 16 + fr; const int nb = row_batch(r);
                const void* src = r < MP ? bp : bs; const size_t roff = (size_t)(r < MP ? r : r - MP) * D; const float* gp = gate + (size_t)nb * MODLD; bf16* dst = xo + (size_t)r * D;
#pragma unroll
                for (int bj = 0; bj < 2; ++bj) { const int c = col0 + bj * 128;
                    const f32x4 g0 = *(const f32x4*)(gp + c), g1 = *(const f32x4*)(gp + c + 4); f32x4 x0, x1; ldx8(src, bf32, roff + c, x0, x1);
                    *(v4u*)(dst + c) = pack8(x0 + g0 * acc[ai][bj][m][0], x1 + g1 * acc[ai][bj][m][1]); }
                asm volatile("" ::: "memory"); }
    }
};

struct EpiPartial {
    static constexpr bool PERM = true, AFTER_DRAIN = false;
    float* part; int ld;
    DI void operator()(const f32x4 (&acc)[2][2][4][2], const Unit& u, int wr, int wc, int fr_, int fq_) const {
        const int ln_ = pg8::lane_id_v(), fr = ln_ & 15, fq = ln_ >> 4; (void)fr_; (void)fq_;
        const int col0 = u.pn * 256 + wc * 32 + 8 * fq; float* pb = part + (size_t)u.sl * MS * ld;
#pragma unroll
        for (int ai = 0; ai < 2; ++ai)
#pragma unroll
            for (int m = 0; m < 4; ++m) { const int r = u.pm * 256 + ai * 128 + wr * 64 + m * 16 + fr - MP; float* dst = pb + (size_t)r * ld + col0;
#pragma unroll
                for (int bj = 0; bj < 2; ++bj) { *(f32x4*)(dst + bj * 128) = acc[ai][bj][m][0]; *(f32x4*)(dst + bj * 128 + 4) = acc[ai][bj][m][1]; } }
    }
};

struct EpiSwiGLU {
    static constexpr bool PERM = true, AFTER_DRAIN = false;
    bf16* act;
    DI void operator()(const f32x4 (&acc)[2][2][4][2], const Unit& u, int wr, int wc, int fr_, int fq_) const {
        const int ln_ = pg8::lane_id_v(), fr = ln_ & 15, fq = ln_ >> 4; (void)fr_; (void)fq_;
        const int col0 = u.pn * 128 + wc * 32 + 8 * fq;
#pragma unroll
        for (int ai = 0; ai < 2; ++ai)
#pragma unroll
            for (int m = 0; m < 4; ++m) { const int r = u.pm * 256 + ai * 128 + wr * 64 + m * 16 + fr; f32x4 o[2];
#pragma unroll
                for (int n = 0; n < 2; ++n) { const f32x4 g = acc[ai][0][m][n], up = acc[ai][1][m][n];
#pragma unroll
                    for (int e = 0; e < 4; ++e) { float sg = sigmoidf_(g[e]); if (PROBE_SITE == 15) { float ge = g[e]; asm volatile("" : "+v"(ge)); sg = 0.5f * (sg + sigmoidf_(ge)); } o[n][e] = g[e] * up[e] * sg; } }
                st16_wt(act + (size_t)r * FF + col0, pack8(o[0], o[1])); }
    }
};

struct EpiGLU {
    static constexpr bool PERM = true, AFTER_DRAIN = false;
    bf16* x; const float* gate; const float* bglu;
    DI void operator()(const f32x4 (&acc)[2][2][4][2], const Unit& u, int wr, int wc, int fr_, int fq_) const {
        const int ln_ = pg8::lane_id_v(), fr = ln_ & 15, fq = ln_ >> 4; (void)fr_; (void)fq_;
        const int col0 = u.pn * 128 + wc * 32 + 8 * fq;
        f32x4 ba[2], bb[2];
#pragma unroll
        for (int n = 0; n < 2; ++n) { ba[n] = *(const f32x4*)(bglu + col0 + 4 * n); bb[n] = *(const f32x4*)(bglu + D + col0 + 4 * n); }
#pragma unroll
        for (int ai = 0; ai < 2; ++ai)
#pragma unroll
            for (int m = 0; m < 4; ++m) { const int r = u.pm * 256 + ai * 128 + wr * 64 + m * 16 + fr; const int nb = row_batch(r);
                bf16* xr = x + (size_t)r * D + col0; const float* gp = gate + (size_t)nb * MODLD + col0;
                f32x4 xv[2]; ldx8(xr, 0, 0, xv[0], xv[1]);
#pragma unroll
                for (int n = 0; n < 2; ++n) { const f32x4 a = acc[ai][0][m][n] + ba[n], b = acc[ai][1][m][n] + bb[n]; const f32x4 g = *(const f32x4*)(gp + 4 * n);
#pragma unroll
                    for (int e = 0; e < 4; ++e) xv[n][e] += g[e] * a[e] * sigmoidf_(b[e]); }
                *(v4u*)xr = pack8(xv[0], xv[1]);
                asm volatile("" ::: "memory"); }
    }
};

struct EpiIn {
    static constexpr bool PERM = true, AFTER_DRAIN = false;
    bf16 *U, *Q; const float* rope; float* out; int ei;
    DI void operator()(const f32x4 (&acc)[2][2][4][2], const Unit& u, int wr, int wc, int fr_, int fq_) const {
        const int ln_ = pg8::lane_id_v(), fr = ln_ & 15, fq = ln_ >> 4; (void)fr_; (void)fq_;
        const int pn = u.pn;
        if (pn < 4) {
            const int col0 = pn * 128 + wc * 32 + 8 * fq;
#pragma unroll
            for (int ai = 0; ai < 2; ++ai)
#pragma unroll
                for (int m = 0; m < 4; ++m) { const int r = u.pm * 256 + ai * 128 + wr * 64 + m * 16 + fr; f32x4 o[2];
#pragma unroll
                    for (int n = 0; n < 2; ++n) { const f32x4 v = acc[ai][0][m][n], g = acc[ai][1][m][n];
#pragma unroll
                        for (int e = 0; e < 4; ++e) o[n][e] = v[e] * sigmoidf_(g[e]); }
                    *(v4u*)(U + (size_t)r * CCH + col0) = pack8(o[0], o[1]);
                    float* cp = nullptr;
                    if (r < MP) { const int t = r & (SEQ - 1); if (t >= SEQ - 30) cp = out + O_CONVP + ((size_t)(ei * NB_P + (r >> 12)) * 30 + (t - (SEQ - 30))) * CCH; }
                    else { const int n = (r - MP) >> 3, t = r & 7; cp = out + O_CONVS + ((size_t)(ei * NB_S + n) * 30 + 22 + t) * CCH; }
                    if (cp) { __builtin_nontemporal_store(o[0], (f32x4*)(cp + col0)); __builtin_nontemporal_store(o[1], (f32x4*)(cp + col0 + 4)); } }
            return;
        }
        const int kind = (pn - 4) / 3, g = (pn - 4) % 3;
        const bool do_rope = (kind < 2) && ((wc & 1) == 0);
        bf16* dstb = Q + (size_t)kind * ((WS_K - WS_Q) / 2);
        const int keep = 128 << (2 * g);
        const size_t okvp = O_KV0P + (size_t)4096 * 128 * (((1 << (2 * g)) - 1) / 3), okvs = O_KV0S + (size_t)g * (O_KV1S - O_KV0S);
#pragma unroll
        for (int ai = 0; ai < 2; ++ai)
#pragma unroll
            for (int m = 0; m < 4; ++m) { const int r = u.pm * 256 + ai * 128 + wr * 64 + m * 16 + fr;
                const int pos = r < MP ? (r & (SEQ - 1)) : 2048 + (r & 7);
                f32x4 cs0 = {1.f, 1.f, 1.f, 1.f}, cs1 = cs0, sn0 = {0.f, 0.f, 0.f, 0.f}, sn1 = sn0;
                if (do_rope) { const float* rp = rope + (size_t)pos * 16; cs0 = *(const f32x4*)(rp); cs1 = *(const f32x4*)(rp + 4); sn0 = *(const f32x4*)(rp + 8); sn1 = *(const f32x4*)(rp + 12);
                    if (fq == 0) { sn0 = -sn0; sn1 = -sn1; } }
                float* kvp = nullptr;
                if (kind > 0) {
                    if (r < MP) { const int t = r & (SEQ - 1); if (t >= SEQ - keep) kvp = out + okvp + (((size_t)(ei * NB_P + (r >> 12)) * keep + (t - (SEQ - keep))) * 2 + (kind - 1)) * 256; }
                    else { const int n = (r - MP) >> 3, t = r & 7; kvp = out + okvs + (((size_t)(ei * NB_S + n) * 8 + t) * 2 + (kind - 1)) * 256; }
                }
#pragma unroll
                for (int bj = 0; bj < 2; ++bj) { f32x4 v0 = acc[ai][bj][m][0], v1 = acc[ai][bj][m][1];
                    if (do_rope) {
                        f32x4 p0, p1;
#pragma unroll
                        for (int e = 0; e < 4; ++e) { p0[e] = shx<16>(v0[e]); p1[e] = shx<16>(v1[e]); }
                        if (fq < 2) { v0 = v0 * cs0 + p0 * sn0; v1 = v1 * cs1 + p1 * sn1; }
                    }
                    if (kind == 0) { v0 = v0 * QSCALE; v1 = v1 * QSCALE; }
                    const int cc = bj * 128 + wc * 32 + 8 * fq;
                    *(v4u*)(dstb + (size_t)r * ATW + g * 256 + cc) = pack8(v0, v1);
                    if (kvp) { __builtin_nontemporal_store(v0, (f32x4*)(kvp + cc)); __builtin_nontemporal_store(v1, (f32x4*)(kvp + cc + 4)); } }
                asm volatile("" ::: "memory"); }
    }
};

struct Frame {
    LAS unsigned char* lds;
    volatile LAS unsigned* MISC;
    gu32* ctl;
    int wave, G, NGW;
    int lane, tid, gw;
    unsigned char* ws; float* out;
};

#define PH_IDS(F) do { (F).lane = pg8::lane_id_v(); (F).ws = opaque_uniform((F).ws); (F).out = opaque_uniform((F).out); { int wv_ = __builtin_amdgcn_readfirstlane((F).wave); asm volatile("" : "+s"(wv_)); (F).wave = wv_; } (F).tid = (F).wave * 64 + (F).lane; (F).gw = (int)blockIdx.x * NWAVES + (F).wave; } while (0)
DI double exp_small(double x) {
    const double y = x * (1.0 / 1024.0);
    double r = 1.0 / 362880.0;
    r = r * y + 1.0 / 40320.0; r = r * y + 1.0 / 5040.0; r = r * y + 1.0 / 720.0; r = r * y + 1.0 / 120.0; r = r * y + 1.0 / 24.0; r = r * y + 1.0 / 6.0; r = r * y + 0.5; r = r * y + 1.0; r = r * y + 1.0;
#pragma unroll
    for (int i = 0; i < 10; ++i) r = r * r;
    return r;
}
DI void sincos_d(double x, double& s, double& c) {
    const double TWO_PI_HI = 6.283185307179586232, TWO_PI_LO = 2.4492935982947064e-16;
    const double k = __builtin_rint(x * 0.15915494309189535);
    double r = __builtin_fma(-k, TWO_PI_HI, x); r = __builtin_fma(-k, TWO_PI_LO, r);
    const double y = r * 0.25, y2 = y * y;
    double sp = -1.0 / 1307674368000.0;
    sp = sp * y2 + 1.0 / 6227020800.0; sp = sp * y2 - 1.0 / 39916800.0; sp = sp * y2 + 1.0 / 362880.0; sp = sp * y2 - 1.0 / 5040.0; sp = sp * y2 + 1.0 / 120.0; sp = sp * y2 - 1.0 / 6.0; sp = sp * y2 + 1.0;
    double s1 = sp * y;
    double cp = 1.0 / 20922789888000.0;
    cp = cp * y2 - 1.0 / 87178291200.0; cp = cp * y2 + 1.0 / 479001600.0; cp = cp * y2 - 1.0 / 3628800.0; cp = cp * y2 + 1.0 / 40320.0; cp = cp * y2 - 1.0 / 720.0; cp = cp * y2 + 1.0 / 24.0; cp = cp * y2 - 0.5; cp = cp * y2 + 1.0;
    double c1 = cp;
#pragma unroll
    for (int i = 0; i < 2; ++i) { const double s2 = 2.0 * s1 * c1, c2 = c1 * c1 - s1 * s1; s1 = s2; c1 = c2; }
    s = s1; c = c1;
}

#ifndef PROLOGUE_BATCHED
#define PROLOGUE_BATCHED 1
#endif
DI int map_row(int mode, int n) {
    if (mode == 1) { if (n < 512) return 256 * (n >> 7) + (n & 127); if (n < 1024) { const int q = n - 512; return 256 * (q >> 7) + 128 + (q & 127); } return n; }
    if (mode == 2) return 256 * (n >> 7) + (n & 127);
    if (mode == 3) return 256 * (n >> 7) + 128 + (n & 127);
    if (mode == 4) { if (n < 1024) return 256 * (n >> 7) + (n & 127); const int q = n - 1024; return 256 * (q >> 7) + 128 + (q & 127); }
    return n;
}
DI void p0_transpose_item(const float* W, int K, int N, bf16* WT, int mode, int row_off, LAS float* scr, int item, int lane) {
    const int nblk = N / 32, kb = item / nblk, nb = item % nblk, k0 = 64 * kb, n0 = 32 * nb;
#if PROLOGUE_BATCHED
    float wv[32];
#pragma unroll
    for (int i = 0; i < 32; ++i) { const int kk = 2 * i + (lane >> 5); wv[i] = __builtin_nontemporal_load(W + (size_t)(k0 + kk) * N + n0 + (lane & 31)); }
#pragma unroll
    for (int i = 0; i < 32; ++i) { const int kk = 2 * i + (lane >> 5); scr[kk * 33 + (lane & 31)] = wv[i]; }
#else
#pragma unroll 8
    for (int i = 0; i < 32; ++i) { const int kk = 2 * i + (lane >> 5); scr[kk * 33 + (lane & 31)] = W[(size_t)(k0 + kk) * N + n0 + (lane & 31)]; }
#endif
    LDS_WAIT(); asm volatile("" ::: "memory");
    const int c = lane & 7; const int r0 = map_row(mode, n0) + row_off;
#pragma unroll
    for (int j = 0; j < 4; ++j) { const int n = (lane >> 3) + 8 * j; const LAS float* s = scr + (8 * c) * 33 + n;
        v4u o; o.x = pk2(s[0 * 33], s[1 * 33]); o.y = pk2(s[2 * 33], s[3 * 33]); o.z = pk2(s[4 * 33], s[5 * 33]); o.w = pk2(s[6 * 33], s[7 * 33]);
        *(GAS v4u*)(WT + (size_t)(r0 + n) * K + k0 + 8 * c) = o; }
    LDS_WAIT(); asm volatile("" ::: "memory");
}

struct Ins { const float* p[32]; };

constexpr int P0_NITEMS = 2 * 16 * 104 + 2 * 12 * 32 + 2 * 16 * 64 + 8 * 16 * 88 + 4 * 44 * 32 + 4 * 16 * 192, P0_ADA_ITEMS = 4 * 16 * 192, P0_DEFER = 0;
DI void p0_items(Frame& F, const Ins& I, int lo, int hi, int wi, int nw) {
    LAS float* scr = (LAS float*)(F.lds + RING_OFF + F.wave * 16384);
    unsigned char* ws = F.ws;
    constexpr int I_IN = 16 * 104, I_O = 12 * 32, I_GLU = 16 * 64, I_G = 16 * 88, I_D = 44 * 32, I_ADA = 16 * 192;
    constexpr int NITEMS = 2 * I_IN + 2 * I_O + 2 * I_GLU + 8 * I_G + 4 * I_D + 4 * I_ADA; static_assert(NITEMS == P0_NITEMS && 4 * I_ADA == P0_ADA_ITEMS, "item counts");
    for (int it = lo + wi; it < hi; it += nw) {
        int r = it;
        if (r < 2 * I_IN) { const int e = r / I_IN; p0_transpose_item(I.p[13] + (size_t)e * D * INC, D, INC, (bf16*)(ws + WS_WIN) + (size_t)e * INC * D, 1, 0, scr, r % I_IN, F.lane); continue; } r -= 2 * I_IN;
        if (r < 2 * I_O) { const int e = r / I_O; p0_transpose_item(I.p[18] + (size_t)e * MIXK * D, MIXK, D, (bf16*)(ws + WS_WO) + (size_t)e * D * MIXK, 0, 0, scr, r % I_O, F.lane); continue; } r -= 2 * I_O;
        if (r < 2 * I_GLU) { const int e = r / I_GLU; p0_transpose_item(I.p[27] + (size_t)e * D * 2 * D, D, 2 * D, (bf16*)(ws + WS_WGLU) + (size_t)e * 2 * D * D, 4, 0, scr, r % I_GLU, F.lane); continue; } r -= 2 * I_GLU;
        if (r < 4 * I_G) { const int e = r / I_G; p0_transpose_item(I.p[29] + (size_t)e * D * FF, D, FF, (bf16*)(ws + WS_WGU) + (size_t)e * 2 * FF * D, 2, 0, scr, r % I_G, F.lane); continue; } r -= 4 * I_G;
        if (r < 4 * I_G) { const int e = r / I_G; p0_transpose_item(I.p[30] + (size_t)e * D * FF, D, FF, (bf16*)(ws + WS_WGU) + (size_t)e * 2 * FF * D, 3, 0, scr, r % I_G, F.lane); continue; } r -= 4 * I_G;
        if (r < 4 * I_D) { const int e = r / I_D; p0_transpose_item(I.p[31] + (size_t)e * FF * D, FF, D, (bf16*)(ws + WS_WD) + (size_t)e * D * FF, 0, 0, scr, r % I_D, F.lane); continue; } r -= 4 * I_D;
        { const int e = r / I_ADA; p0_transpose_item(I.p[11] + (size_t)e * D * 6144, D, 6144, (bf16*)(ws + WS_WADA), 0, e * 6144, scr, r % I_ADA, F.lane); }
    }
}
DI void p0_prologue(Frame& F, const Ins& I) {
    PH_IDS(F);
    unsigned char* ws = F.ws;
    p0_items(F, I, P0_NITEMS - P0_ADA_ITEMS, P0_NITEMS, F.gw, F.NGW);
    const int gt = F.gw * 64 + F.lane, NGT = F.NGW * 64;
    { bf16* sc = (bf16*)(ws + WS_SILC);
      for (int i = gt; i < 256 * D; i += NGT) { const int r = i >> 10, c = i & 1023; float v = 0.f;
          if (r < NB_P) v = I.p[7][r * D + c]; else if (r < NBT) v = I.p[8][(r - NB_P) * D + c];
          sc[i] = (bf16)f2bf(v * sigmoidf_(v)); } }
    { float* rt = (float*)(ws + WS_ROPE);
      for (int i = gt; i < 4096 * 8; i += NGT) { const int pos = i >> 3, k = i & 7;
          const double inv = exp_small(-(double)k * (13.122363377404328 / 8.0)); double s, c; sincos_d((double)pos * inv, s, c);
          rt[pos * 16 + k] = (float)c; rt[pos * 16 + 8 + k] = (float)s; } }
    { float* AB = (float*)(ws + WS_S5AB); float* ABT = (float*)(ws + WS_S5ABT); float* BB = (float*)(ws + WS_S5BB);
      for (int i = gt; i < 2 * 64 * 64; i += NGT) { const int og = i >> 6;
          const double lr = I.p[19][i], li = I.p[20][i], dt = exp_small((double)I.p[21][og]);
          const double mag = exp_small(lr * dt); double sn, cs; sincos_d(li * dt, sn, cs);
          const double abr = mag * cs, abi = mag * sn, den = lr * lr + li * li, nr = abr - 1.0;
          const double fr_ = (nr * lr + abi * li) / den, fi_ = (abi * lr - nr * li) / den;
          AB[2 * i] = (float)abr; AB[2 * i + 1] = (float)abi;
          double pr = abr, pi = abi;
#pragma unroll
          for (int q = 0; q < 7; ++q) { const double t = pr * pr - pi * pi; pi = 2.0 * pr * pi; pr = t; }
          ABT[2 * i] = (float)pr; ABT[2 * i + 1] = (float)pi;
          for (int ch = 0; ch < 16; ++ch) { const double br = I.p[22][(size_t)i * 16 + ch], bi = I.p[23][(size_t)i * 16 + ch];
              BB[(size_t)i * 32 + ch] = (float)(fr_ * br - fi_ * bi); BB[(size_t)i * 32 + 16 + ch] = (float)(fr_ * bi + fi_ * br); } } }
    { const float* cc = I.p[2]; float* o = F.out + O_CONVS;
      for (int i = gt; i < 2 * NB_S * 22 * (CCH / 4); i += NGT) { const int c4 = i & 127, rr = (i >> 7) % 22, bn = (i >> 7) / 22;
          *(f32x4*)(o + ((size_t)bn * 30 + rr) * CCH + 4 * c4) = *(const f32x4*)(cc + ((size_t)bn * 30 + 8 + rr) * CCH + 4 * c4); } }
}

template <bool FINAL>
DI void norm_phase(Frame& F, const void* xp, const void* xs, int xf32, const float* gain, const float* msh, const float* msc, bf16* outb, float* outf, const float* part, int nsl, const float* pgate, bf16* xdst, const float* bglu = nullptr) {
    PH_IDS(F);
    f32x4 g[4];
#pragma unroll
    for (int j = 0; j < 4; ++j) g[j] = *(const f32x4*)(gain + 4 * F.lane + 256 * j);
    auto load_mod = [&](f32x4 (&pa)[4], f32x4 (&pb)[4], int nb) {
        if (!FINAL) { const float* sh = msh + (size_t)nb * MODLD; const float* sc = msc + (size_t)nb * MODLD;
#pragma unroll
            for (int j = 0; j < 4; ++j) { pa[j] = *(const f32x4*)(sc + 4 * F.lane + 256 * j); pb[j] = *(const f32x4*)(sh + 4 * F.lane + 256 * j); } }
    };
    auto finish_row = [&](f32x4 (&vr)[4], int row, const f32x4 (&pa)[4], const f32x4 (&pb)[4], int nbp) {
        float ss = 0.f;
#pragma unroll
        for (int j = 0; j < 4; ++j) ss += (vr[j].x * vr[j].x + vr[j].y * vr[j].y) + (vr[j].z * vr[j].z + vr[j].w * vr[j].w);
        const float rstd = __builtin_amdgcn_rsqf(wave_sum(ss) * (1.f / D) + EPS);
        if (FINAL) {
#pragma unroll
            for (int j = 0; j < 4; ++j) __builtin_nontemporal_store(vr[j] * rstd * g[j], (f32x4*)(outf + (size_t)row * D + 4 * F.lane + 256 * j));
        } else {
            const int nb = row_batch(row); f32x4 qa[4], qb[4];
            if (nb != nbp) load_mod(qa, qb, nb);
            else {
#pragma unroll
                for (int j = 0; j < 4; ++j) { qa[j] = pa[j]; qb[j] = pb[j]; } }
#pragma unroll
            for (int j = 0; j < 4; ++j) { const f32x4 a = qa[j], b = qb[j];
                const f32x4 h = vr[j] * rstd * g[j] * (a + 1.f) + b;
                v2u w; w.x = pk2(h.x, h.y); w.y = pk2(h.z, h.w); st8_wt(outb + (size_t)row * D + 4 * F.lane + 256 * j, w.x, w.y); }
        }
    };
    constexpr int RB = 4;
    int pstart = F.gw, pstride = F.NGW, pend = MP;
    const bool split = F.G * 4 == MS;
    if (nsl > 0 && split) { const int xq = (int)blockIdx.x & 7, lw = ((int)blockIdx.x >> 3) * 4 + (F.wave & 3); pstride = 128;
        if (F.wave < 4) { pstart = 2048 * xq + lw; pend = 2048 * xq + 512; } else { pstart = 2048 * xq + 512 + lw; pend = 2048 * xq + 2048; } }
    for (int row0 = pstart; row0 < pend; row0 += RB * pstride) {
        f32x4 v[RB][4], pa[4], pb[4]; const int nb0 = row0 >> 12;
        load_mod(pa, pb, nb0);
#pragma unroll
        for (int q = 0; q < RB; ++q) { const int row = row0 + q * pstride;
            if (row < pend) { const size_t roff = (size_t)row * D + 4 * F.lane;
                if (xf32 == 1) {
#pragma unroll
                    for (int j = 0; j < 4; ++j) v[q][j] = *(const f32x4*)((const float*)xp + roff + 256 * j);
                } else {
#pragma unroll
                    for (int j = 0; j < 4; ++j) { const v2u w = *(const v2u*)((const bf16*)xp + roff + 256 * j); v[q][j] = (f32x4){bflo(w.x), bfhi(w.x), bflo(w.y), bfhi(w.y)}; }
                }
            } }
#pragma unroll
        for (int q = 0; q < RB; ++q) { const int row = row0 + q * pstride; if (row < pend) finish_row(v[q], row, pa, pb, nb0); }
    }
    {
#pragma unroll 1
        for (int sr = split ? (F.wave < 4 ? (int)blockIdx.x * 4 + F.wave : MS) : F.gw; sr < MS; sr += F.NGW) { const int row = MP + sr;
            f32x4 v[4], pa[4], pb[4]; const size_t roff = (size_t)sr * D + 4 * F.lane; const int nbs = row_batch(row);
            load_mod(pa, pb, nbs);
            if (xf32 != 0) {
#pragma unroll
                for (int j = 0; j < 4; ++j) v[j] = *(const f32x4*)((const float*)xs + roff + 256 * j);
            } else {
#pragma unroll
                for (int j = 0; j < 4; ++j) { const v2u w = *(const v2u*)((const bf16*)xs + roff + 256 * j); v[j] = (f32x4){bflo(w.x), bfhi(w.x), bflo(w.y), bfhi(w.y)}; }
            }
            if (nsl > 0) {
                const float* pp = part + (size_t)sr * D + 4 * F.lane; const float* gp = pgate + (size_t)row_batch(row) * MODLD + 4 * F.lane;
                f32x4 gt_[4];
#pragma unroll
                for (int j = 0; j < 4; ++j) gt_[j] = *(const f32x4*)(gp + 256 * j);
                f32x4 sacc[4];
                if (bglu) {
                    const float* pq = part + (size_t)sr * (2 * D) + 256 * (F.lane >> 5) + 4 * (F.lane & 31);
                    f32x4 sa[4], sb[4];
#pragma unroll
                    for (int j = 0; j < 4; ++j) { sa[j] = *(const f32x4*)(bglu + 4 * F.lane + 256 * j); sb[j] = *(const f32x4*)(bglu + D + 4 * F.lane + 256 * j); }
#pragma unroll 1
                    for (int sl0 = 0; sl0 < nsl; sl0 += 2) {
                        f32x4 ta[2][4], tb[2][4];
#pragma unroll
                        for (int u = 0; u < 2; ++u) { const int sl = sl0 + u < nsl ? sl0 + u : sl0;
#pragma unroll
                            for (int j = 0; j < 4; ++j) { ta[u][j] = *(const f32x4*)(pq + (size_t)sl * MS * 2 * D + 512 * j); tb[u][j] = *(const f32x4*)(pq + (size_t)sl * MS * 2 * D + 512 * j + 128); } }
#pragma unroll
                        for (int u = 0; u < 2; ++u) if (sl0 + u < nsl) {
#pragma unroll
                            for (int j = 0; j < 4; ++j) { sa[j] += ta[u][j]; sb[j] += tb[u][j]; } }
                    }
#pragma unroll
                    for (int j = 0; j < 4; ++j)
#pragma unroll
                        for (int e = 0; e < 4; ++e) sacc[j][e] = sa[j][e] * sigmoidf_(sb[j][e]);
                } else {
#pragma unroll
                    for (int j = 0; j < 4; ++j) sacc[j] = (f32x4){0.f, 0.f, 0.f, 0.f};
#pragma unroll 1
                    for (int sl0 = 0; sl0 < nsl; sl0 += 4) {
                        f32x4 tp[4][4];
#pragma unroll
                        for (int u = 0; u < 4; ++u) { const int sl = sl0 + u < nsl ? sl0 + u : sl0;
#pragma unroll
                            for (int j = 0; j < 4; ++j) tp[u][j] = *(const f32x4*)(pp + (size_t)sl * MS * D + 256 * j); }
#pragma unroll
                        for (int u = 0; u < 4; ++u) if (sl0 + u < nsl) {
#pragma unroll
                            for (int j = 0; j < 4; ++j) sacc[j] += tp[u][j]; }
                    }
                }
#pragma unroll
                for (int j = 0; j < 4; ++j) { v[j] += gt_[j] * sacc[j];
                    v2u w; w.x = pk2(v[j].x, v[j].y); w.y = pk2(v[j].z, v[j].w); *(v2u*)(xdst + (size_t)row * D + 4 * F.lane + 256 * j) = w;
                    v[j] = (f32x4){bflo(w.x), bfhi(w.x), bflo(w.y), bfhi(w.y)}; }
            }
            finish_row(v, row, pa, pb, nbs);
        }
    }
}

DI float red16(float v) { v += shx<1>(v); v += shx<2>(v); v += shx<4>(v); v += shx<8>(v); return v; }
DI void attn_unit_valu(Frame& F, const float* cbase, int row, int g, int ei) {
    const bf16* Qb = (const bf16*)(F.ws + WS_Q); const bf16* Kb = (const bf16*)(F.ws + WS_K); const bf16* Vb = (const bf16*)(F.ws + WS_V);
    const int lane = F.lane, dil = 1 << (2 * g), wb = 128 << (2 * g);
    const v2u qw = *(const v2u*)(Qb + (size_t)row * ATW + g * 256 + 4 * lane);
    const float q0 = bflo(qw.x), q1 = bfhi(qw.x), q2 = bflo(qw.y), q3 = bfhi(qw.y);
    float m = -1e30f, l = 0.f, a0 = 0.f, a1 = 0.f, a2 = 0.f, a3 = 0.f;
    if (row < MP) {
        const int n = row >> 12, t = row & (SEQ - 1);
        int nk = t / dil; nk = (nk < 128 ? nk : 128) + 1;
        const bf16* kp = Kb + ((size_t)n * SEQ + t) * ATW + g * 256 + 4 * lane; const bf16* vp = Vb + ((size_t)n * SEQ + t) * ATW + g * 256 + 4 * lane;
        const ptrdiff_t step = -(ptrdiff_t)dil * ATW;
#pragma unroll 4
        for (int j = 0; j < nk; ++j) {
            const v2u kw = *(const v2u*)(kp + j * step), vw = *(const v2u*)(vp + j * step);
            float s = q0 * bflo(kw.x) + q1 * bfhi(kw.x) + q2 * bflo(kw.y) + q3 * bfhi(kw.y);
            s = red16(s);
            const float mn = fmaxf(m, s), al = fast_exp2(m - mn), p = fast_exp2(s - mn);
            l = l * al + p; a0 = a0 * al + p * bflo(vw.x); a1 = a1 * al + p * bfhi(vw.x); a2 = a2 * al + p * bflo(vw.y); a3 = a3 * al + p * bfhi(vw.y); m = mn;
        }
    } else {
        const int n = (row - MP) >> 3, t = row & 7;
        const float* cache = cbase + ((size_t)(ei * NB_S + n) * wb) * 512;
        const float* fresh = F.out + O_KV0S + (size_t)g * (O_KV1S - O_KV0S) + ((size_t)(ei * NB_S + n) * 8) * 512;
#pragma unroll 4
        for (int j = 0; j <= 128; ++j) {
            const int idx = wb + t - dil * j;
            const float* rp = idx >= wb ? fresh + (size_t)(idx - wb) * 512 : cache + (size_t)idx * 512;
            const f32x4 kv = *(const f32x4*)(rp + 4 * lane), vv = *(const f32x4*)(rp + 256 + 4 * lane);
            float s = q0 * kv.x + q1 * kv.y + q2 * kv.z + q3 * kv.w;
            s = red16(s);
            const float mn = fmaxf(m, s), al = fast_exp2(m - mn), p = fast_exp2(s - mn);
            l = l * al + p; a0 = a0 * al + p * vv.x; a1 = a1 * al + p * vv.y; a2 = a2 * al + p * vv.z; a3 = a3 * al + p * vv.w; m = mn;
        }
    }
    const float inv = 1.f / l;
    float* og = (float*)(F.ws + WS_OG) + ((size_t)g * M + row) * 256 + 4 * lane;
    *(f32x4*)og = (f32x4){a0 * inv, a1 * inv, a2 * inv, a3 * inv};
    if ((lane & 15) == 0) ((float*)(F.ws + WS_LSE))[row < MP ? lse_idx_p(g, row >> 12, lane >> 4, row & (SEQ - 1)) : lse_idx_s(g, row - MP, lane >> 4)] = m + fast_log2(l);
}
DI void attn_phase_v1(Frame& F, const Ins& I, int ei) {
    PH_IDS(F);
    for (int u = F.gw; u < 3 * M; u += F.NGW) { const int g = u / M; const float* cbase = I.p[3]; if (g == 1) cbase = I.p[4]; if (g == 2) cbase = I.p[5]; attn_unit_valu(F, cbase, u - g * M, g, ei); }
}

DI void merge_rows(Frame& F) {
    PH_IDS(F);
    const bf16* OG = (const bf16*)(F.ws + WS_OG); const float* LS = (const float*)(F.ws + WS_LSE); bf16* MX = (bf16*)(F.ws + WS_MIX);
    const int lane = F.lane, h = lane >> 4;
    constexpr int RB = 9;
    for (int row0 = F.gw; row0 < M; row0 += RB * F.NGW) {
        float ls[RB][3]; v2u ug[RB][3];
#pragma unroll
        for (int q = 0; q < RB; ++q) { const int row = row0 + q * F.NGW;
            if (row < M) {
#pragma unroll
                for (int gq = 0; gq < 3; ++gq) { ls[q][gq] = LS[row < MP ? lse_idx_p(gq, row >> 12, h, row & (SEQ - 1)) : lse_idx_s(gq, row - MP, h)]; ug[q][gq] = *(const v2u*)(OG + ((size_t)gq * M + row) * 256 + 4 * lane); } } }
#pragma unroll
        for (int q = 0; q < RB; ++q) { const int row = row0 + q * F.NGW;
            if (row < M) {
                const float mx = fmaxf(ls[q][0], fmaxf(ls[q][1], ls[q][2])); const float w0 = fast_exp2(ls[q][0] - mx), w1 = fast_exp2(ls[q][1] - mx), w2 = fast_exp2(ls[q][2] - mx); const float inv = 1.f / (w0 + w1 + w2);
                const f32x4 o0 = {bflo(ug[q][0].x), bfhi(ug[q][0].x), bflo(ug[q][0].y), bfhi(ug[q][0].y)}, o1 = {bflo(ug[q][1].x), bfhi(ug[q][1].x), bflo(ug[q][1].y), bfhi(ug[q][1].y)}, o2 = {bflo(ug[q][2].x), bfhi(ug[q][2].x), bflo(ug[q][2].y), bfhi(ug[q][2].y)};
                const f32x4 a = (o0 * w0 + o1 * w1 + o2 * w2) * inv;
                st8_wt(MX + (size_t)row * MIXK + CCH + 4 * lane, pk2(a.x, a.y), pk2(a.z, a.w)); } }
    }
}

DI void conv_phase(Frame& F, const Ins& I, int ei) {
    PH_IDS(F);
    const bf16* U = (const bf16*)(F.ws + WS_U); bf16* MX = (bf16*)(F.ws + WS_MIX);
    const float* cw = I.p[14] + (size_t)ei * 31 * CCH; const float* cb = I.p[15] + ei * CCH; const float* lg = I.p[16] + ei * CCH; const float* lb = I.p[17] + ei * CCH;
    LAS unsigned char* tile = F.lds + RING_OFF;
    LAS float* stats = (LAS float*)(F.lds + RING_OFF + 96 * 1024);
    LAS float* mr = stats + 64 * 8;
    const int tid = F.tid, lane = F.lane, wave = F.wave, qd = wave & 3, th = wave >> 2, ch = 128 * qd + 2 * lane;
    typedef __bf16 bf16x2_t __attribute__((ext_vector_type(2)));
    unsigned wa[31], wb[31];
#pragma unroll
    for (int j = 0; j < 31; ++j) { const f32x2 w = *(const f32x2*)(cw + j * CCH + ch); wa[j] = f2bf(w.x); wb[j] = f2bf(w.y) << 16; }
    const f32x2 bias = *(const f32x2*)(cb + ch), lgv = *(const f32x2*)(lg + ch), lbv = *(const f32x2*)(lb + ch);
    constexpr int NPT = MP / 64, NUNITS = NPT + NB_S;
    for (int u = blockIdx.x; u < NUNITS; u += F.G) {
        __syncthreads();
        int nout, orow0;
        if (u < NPT) {
            nout = 64; orow0 = u * 64; const int t0 = orow0 & (SEQ - 1);
            for (int i = tid; i < 94 * 64; i += 512) { const int r = i >> 6, c = i & 63; const int t = t0 - 30 + r;
                v4u v = (v4u){0u, 0u, 0u, 0u}; if (t >= 0) v = *(const v4u*)(U + (size_t)(orow0 - 30 + r) * CCH + 8 * c);
                *(LAS v4u*)(tile + r * 1024 + 16 * c) = v; }
        } else {
            const int n = u - NPT; nout = 8; orow0 = MP + n * 8; const float* hist = I.p[2] + (size_t)(ei * NB_S + n) * 30 * CCH;
            for (int i = tid; i < 38 * 64; i += 512) { const int r = i >> 6, c = i & 63; v4u v;
                if (r < 30) { const f32x4 a = *(const f32x4*)(hist + (size_t)r * CCH + 8 * c), b = *(const f32x4*)(hist + (size_t)r * CCH + 8 * c + 4); v.x = pk2(a.x, a.y); v.y = pk2(a.z, a.w); v.z = pk2(b.x, b.y); v.w = pk2(b.z, b.w); }
                else v = *(const v4u*)(U + (size_t)(orow0 + r - 30) * CCH + 8 * c);
                *(LAS v4u*)(tile + r * 1024 + 16 * c) = v; }
        }
        __syncthreads();
        const int half = nout >> 1, tk0 = th * half;
        float y0[32], y1[32];
#pragma unroll
        for (int k = 0; k < 32; ++k) {
            y0[k] = 0.f; y1[k] = 0.f;
            if (k < half) {
                float s0 = bias.x, s1 = bias.y; const LAS unsigned char* tp = tile + (tk0 + k) * 1024 + 2 * ch;
#pragma unroll
                for (int j = 0; j < 31; ++j) { const unsigned w = *(const LAS unsigned*)(tp + j * 1024);
                    s0 = __builtin_amdgcn_fdot2_f32_bf16(__builtin_bit_cast(bf16x2_t, w), __builtin_bit_cast(bf16x2_t, wa[j]), s0, false);
                    s1 = __builtin_amdgcn_fdot2_f32_bf16(__builtin_bit_cast(bf16x2_t, w), __builtin_bit_cast(bf16x2_t, wb[j]), s1, false); }
                y0[k] = s0; y1[k] = s1;
                const float a = wave_sum(s0 + s1), b = wave_sum(s0 * s0 + s1 * s1);
                if (lane == 0) { stats[((tk0 + k) * 4 + qd) * 2] = a; stats[((tk0 + k) * 4 + qd) * 2 + 1] = b; }
            }
        }
        __syncthreads();
        if (tid < nout) { const LAS float* s = stats + tid * 8; const float sm = (s[0] + s[2]) + (s[4] + s[6]), sq = (s[1] + s[3]) + (s[5] + s[7]);
            const float mean = sm * (1.f / CCH), var = sq * (1.f / CCH) - mean * mean; mr[tid * 2] = mean; mr[tid * 2 + 1] = __builtin_amdgcn_rsqf(fmaxf(var, 0.f) + EPS); }
        __syncthreads();
#pragma unroll
        for (int k = 0; k < 32; ++k) {
            if (k < half) { const float mean = mr[(tk0 + k) * 2], rstd = mr[(tk0 + k) * 2 + 1];
                float z0 = (y0[k] - mean) * rstd * lgv.x + lbv.x, z1 = (y1[k] - mean) * rstd * lgv.y + lbv.y;
                z0 = z0 * sigmoidf_(z0); z1 = z1 * sigmoidf_(z1);
                *(unsigned*)(MX + (size_t)(orow0 + tk0 + k) * MIXK + ch) = pk2(z0, z1); }
        }
    }
    __syncthreads();
}

typedef pg8::bf16x8 bf16x8;
typedef float f32x16 __attribute__((ext_vector_type(16)));
typedef short s16x4 __attribute__((ext_vector_type(4)));
#define MFMA32(a, b, c) __builtin_amdgcn_mfma_f32_32x32x16_bf16((a), (b), (c), 0, 0, 0)
DI int crow(int reg, int h2) { return (reg & 3) + 8 * (reg >> 2) + 4 * h2; }
DI bf16x8 pack_step(const f32x16& x, int s) {
    v4u p;
    p.x = pg8::cvt_pk_bf16(x[8 * s], x[8 * s + 1]); p.y = pg8::cvt_pk_bf16(x[8 * s + 2], x[8 * s + 3]); p.z = pg8::cvt_pk_bf16(x[8 * s + 4], x[8 * s + 5]); p.w = pg8::cvt_pk_bf16(x[8 * s + 6], x[8 * s + 7]);
    return __builtin_bit_cast(bf16x8, p);
}
constexpr int VROWB = 144;
DI void attn_prompt_unit(Frame& F, int unit, LAS unsigned char* vl) {
    const bf16* Qb = (const bf16*)(F.ws + WS_Q); const bf16* Kb = (const bf16*)(F.ws + WS_K); const bf16* Vb = (const bf16*)(F.ws + WS_V);
    const int lane = F.lane, c = lane & 31, h2 = lane >> 5;
    const int qt = unit & 127, ngh = unit >> 7, h = ngh & 3, ng = ngh >> 2, g = ng % 3, n = ng / 3;
    const int sh = 2 * g, dil = 1 << sh, tpr = 128 >> sh;
    const int r = qt / tpr, j = qt - r * tpr;
    const size_t rowbase = (size_t)n * SEQ + r;
    const int coloff = g * 256 + h * 64 + 8 * h2;
    bf16x8 qf[4];
    { const bf16* qp = Qb + (rowbase + (size_t)(32 * j + c) * dil) * ATW + coloff;
#pragma unroll
      for (int s = 0; s < 4; ++s) qf[s] = *(const bf16x8*)(qp + 16 * s); }
    bf16x8 kf[5][4];
#pragma unroll
    for (int kt = 0; kt < 5; ++kt) { const int kb = j - 4 + kt; const int kbc = kb < 0 ? 0 : kb;
        const bf16* kp = Kb + (rowbase + (size_t)(32 * kbc + c) * dil) * ATW + coloff;
#pragma unroll
        for (int s = 0; s < 4; ++s) kf[kt][s] = *(const bf16x8*)(kp + 16 * s); }
    f32x16 S[5];
#pragma unroll
    for (int kt = 0; kt < 5; ++kt) {
        const int kb = j - 4 + kt;
        f32x16 a;
#pragma unroll
        for (int i = 0; i < 16; ++i) a[i] = 0.f;
#pragma unroll
        for (int s = 0; s < 4; ++s) a = MFMA32(kf[kt][s], qf[s], a);
        if (kt == 0) {
#pragma unroll
            for (int i = 0; i < 16; ++i) a[i] = crow(i, h2) >= c ? a[i] : -1e30f;
        }
        if (kt == 4) {
#pragma unroll
            for (int i = 0; i < 16; ++i) a[i] = crow(i, h2) <= c ? a[i] : -1e30f;
        }
        if (kb < 0) {
#pragma unroll
            for (int i = 0; i < 16; ++i) a[i] = -1e30f;
        }
        S[kt] = a;
    }
    bf16x8 vf[5][4];
#pragma unroll
    for (int kt = 0; kt < 5; ++kt) { const int kb = j - 4 + kt; const int kbc = kb < 0 ? 0 : kb;
        const bf16* vp = Vb + (rowbase + (size_t)(32 * kbc + c) * dil) * ATW + coloff;
#pragma unroll
        for (int s = 0; s < 4; ++s) vf[kt][s] = *(const bf16x8*)(vp + 16 * s); }
    float m = -1e30f;
#pragma unroll
    for (int kt = 0; kt < 5; ++kt)
#pragma unroll
        for (int i = 0; i < 16; ++i) m = fmaxf(m, S[kt][i]);
    m = max32(m);
    float l = 0.f;
#pragma unroll
    for (int kt = 0; kt < 5; ++kt)
#pragma unroll
        for (int i = 0; i < 16; ++i) { const float p = fast_exp2(S[kt][i] - m); S[kt][i] = p; l += p; }
    l = sum32(l);
    f32x16 o0, o1;
#pragma unroll
    for (int i = 0; i < 16; ++i) { o0[i] = 0.f; o1[i] = 0.f; }
    const unsigned wbase = (unsigned)(size_t)vl + (unsigned)(c * VROWB + 16 * h2);
    const int q4 = (lane & 15) >> 2, p4 = lane & 3, gid = (lane >> 4) & 1;
    const unsigned rbase = (unsigned)(size_t)vl + (unsigned)((4 * h2 + q4) * VROWB + (16 * gid + 4 * p4) * 2);
#pragma unroll
    for (int kt = 0; kt < 5; ++kt) {
        const int kb = j - 4 + kt;
        if (kb >= 0) {
#pragma unroll
            for (int s = 0; s < 4; ++s) *(LAS bf16x8*)(size_t)(wbase + 32 * s) = vf[kt][s];
            s16x4 t[8];
            asm volatile("s_waitcnt lgkmcnt(0)\n\t"
                         "ds_read_b64_tr_b16 %0, %8\n\tds_read_b64_tr_b16 %1, %8 offset:1152\n\t"
                         "ds_read_b64_tr_b16 %2, %8 offset:64\n\tds_read_b64_tr_b16 %3, %8 offset:1216\n\t"
                         "ds_read_b64_tr_b16 %4, %8 offset:2304\n\tds_read_b64_tr_b16 %5, %8 offset:3456\n\t"
                         "ds_read_b64_tr_b16 %6, %8 offset:2368\n\tds_read_b64_tr_b16 %7, %8 offset:3520\n\t"
                         "s_waitcnt lgkmcnt(0)"
                         : "=&v"(t[0]), "=&v"(t[1]), "=&v"(t[2]), "=&v"(t[3]), "=&v"(t[4]), "=&v"(t[5]), "=&v"(t[6]), "=&v"(t[7]) : "v"(rbase) : "memory");
            const bf16x8 p0 = pack_step(S[kt], 0), p1 = pack_step(S[kt], 1);
            o0 = MFMA32(__builtin_shufflevector(t[0], t[1], 0, 1, 2, 3, 4, 5, 6, 7), p0, o0);
            o1 = MFMA32(__builtin_shufflevector(t[2], t[3], 0, 1, 2, 3, 4, 5, 6, 7), p0, o1);
            o0 = MFMA32(__builtin_shufflevector(t[4], t[5], 0, 1, 2, 3, 4, 5, 6, 7), p1, o0);
            o1 = MFMA32(__builtin_shufflevector(t[6], t[7], 0, 1, 2, 3, 4, 5, 6, 7), p1, o1);
        }
    }
    const float inv = 1.f / l;
    const size_t row = rowbase + (size_t)(32 * j + c) * dil;
    bf16* og = (bf16*)(F.ws + WS_OG) + ((size_t)g * M + row) * 256 + h * 64 + 4 * h2;
#pragma unroll
    for (int k = 0; k < 4; ++k) {
        v2u w; w.x = pg8::cvt_pk_bf16(o0[4 * k] * inv, o0[4 * k + 1] * inv); w.y = pg8::cvt_pk_bf16(o0[4 * k + 2] * inv, o0[4 * k + 3] * inv); *(v2u*)(og + 8 * k) = w;
        w.x = pg8::cvt_pk_bf16(o1[4 * k] * inv, o1[4 * k + 1] * inv); w.y = pg8::cvt_pk_bf16(o1[4 * k + 2] * inv, o1[4 * k + 3] * inv); *(v2u*)(og + 32 + 8 * k) = w;
    }
    if (h2 == 0) ((float*)(F.ws + WS_LSE))[lse_idx_p(g, n, h, r + (32 * j + c) * dil)] = m + fast_log2(l);
}

struct SmState { float m, l, a0, a1, a2, a3; };
DI void sm_init(SmState& s) { s.m = -1e30f; s.l = 0.f; s.a0 = s.a1 = s.a2 = s.a3 = 0.f; }
DI void sm_step(SmState& s, const f32x4 q, const f32x4 k, const f32x4 v, bool valid) {
    float sc = q.x * k.x + q.y * k.y + q.z * k.z + q.w * k.w;
    sc = red16(sc);
    sc = valid ? sc : -1e30f;
    const float mn = fmaxf(s.m, sc), al = fast_exp2(s.m - mn), p = valid ? fast_exp2(sc - mn) : 0.f;
    s.l = s.l * al + p; s.a0 = s.a0 * al + p * v.x; s.a1 = s.a1 * al + p * v.y; s.a2 = s.a2 * al + p * v.z; s.a3 = s.a3 * al + p * v.w; s.m = mn;
}
DI void sm_store(Frame& F, const SmState& s, int g, int row) {
    const float inv = 1.f / s.l;
    { v2u w; w.x = pk2(s.a0 * inv, s.a1 * inv); w.y = pk2(s.a2 * inv, s.a3 * inv); *(v2u*)((bf16*)(F.ws + WS_OG) + ((size_t)g * M + row) * 256 + 4 * F.lane) = w; }
    if ((F.lane & 15) == 0) ((float*)(F.ws + WS_LSE))[lse_idx_s(g, row - MP, F.lane >> 4)] = s.m + fast_log2(s.l);
}
DI f32x4 ldq(const bf16* Qb, int row, int g, int lane) { const v2u w = *(const v2u*)(Qb + (size_t)row * ATW + g * 256 + 4 * lane); return (f32x4){bflo(w.x), bfhi(w.x), bflo(w.y), bfhi(w.y)}; }
DI void attn_sample_unit(Frame& F, const Ins& I, int unit, int ei) {
    const bf16* Qb = (const bf16*)(F.ws + WS_Q);
    const int lane = F.lane, n = unit >> 4, su = unit & 15;
    const int row0 = MP + n * 8;
    if (su < 8) {
        const int t = su; const f32x4 q = ldq(Qb, row0 + t, 2, lane);
        const float* cache = I.p[5] + ((size_t)(ei * NB_S + n) * 2048 + t) * 512 + 4 * lane;
        const float* fresh = F.out + O_KV2S + ((size_t)(ei * NB_S + n) * 8 + t) * 512 + 4 * lane;
        SmState s; sm_init(s);
#pragma unroll 1
        for (int i0 = 0; i0 < 128; i0 += 8) { f32x4 kk[8], vv[8];
#pragma unroll
            for (int u = 0; u < 8; ++u) { const float* rp = cache + (size_t)(i0 + u) * 16 * 512; kk[u] = __builtin_nontemporal_load((const f32x4*)rp); vv[u] = __builtin_nontemporal_load((const f32x4*)(rp + 256)); }
#pragma unroll
            for (int u = 0; u < 8; ++u) sm_step(s, q, kk[u], vv[u], true); }
        sm_step(s, q, *(const f32x4*)fresh, *(const f32x4*)(fresh + 256), true);
        sm_store(F, s, 2, row0 + t);
    } else if (su < 12) {
        const int r = su - 8; const f32x4 qa = ldq(Qb, row0 + r, 1, lane), qb = ldq(Qb, row0 + r + 4, 1, lane);
        const float* cache = I.p[4] + ((size_t)(ei * NB_S + n) * 512 + r) * 512 + 4 * lane;
        const float* fresh = F.out + O_KV1S + ((size_t)(ei * NB_S + n) * 8) * 512 + 4 * lane;
        SmState sa, sb; sm_init(sa); sm_init(sb);
#pragma unroll 1
        for (int i0 = 0; i0 < 128; i0 += 8) { f32x4 kk[8], vv[8];
#pragma unroll
            for (int u = 0; u < 8; ++u) { const float* rp = cache + (size_t)(i0 + u) * 4 * 512; kk[u] = __builtin_nontemporal_load((const f32x4*)rp); vv[u] = __builtin_nontemporal_load((const f32x4*)(rp + 256)); }
#pragma unroll
            for (int u = 0; u < 8; ++u) { sm_step(sa, qa, kk[u], vv[u], true); sm_step(sb, qb, kk[u], vv[u], (i0 + u) >= 1); } }
        { const float* rp = fresh + (size_t)r * 512; const f32x4 k = *(const f32x4*)rp, v = *(const f32x4*)(rp + 256); sm_step(sa, qa, k, v, true); sm_step(sb, qb, k, v, true); }
        { const float* rp = fresh + (size_t)(r + 4) * 512; sm_step(sb, qb, *(const f32x4*)rp, *(const f32x4*)(rp + 256), true); }
        sm_store(F, sa, 1, row0 + r); sm_store(F, sb, 1, row0 + r + 4);
    } else {
        const int t = 2 * (su - 12); const f32x4 qa = ldq(Qb, row0 + t, 0, lane), qb = ldq(Qb, row0 + t + 1, 0, lane);
        const float* cache = I.p[3] + ((size_t)(ei * NB_S + n) * 128) * 512 + 4 * lane;
        const float* fresh = F.out + O_KV0S + ((size_t)(ei * NB_S + n) * 8) * 512 + 4 * lane;
        SmState sa, sb; sm_init(sa); sm_init(sb);
#pragma unroll 1
        for (int i0 = 0; i0 < 128; i0 += 8) { f32x4 kk[8], vv[8];
#pragma unroll
            for (int u = 0; u < 8; ++u) { const float* rp = cache + (size_t)(i0 + u) * 512; kk[u] = *(const f32x4*)rp; vv[u] = *(const f32x4*)(rp + 256); }
#pragma unroll
            for (int u = 0; u < 8; ++u) { sm_step(sa, qa, kk[u], vv[u], (i0 + u) >= t); sm_step(sb, qb, kk[u], vv[u], (i0 + u) >= t + 1); } }
#pragma unroll 1
        for (int u = 0; u <= t + 1; ++u) { const float* rp = fresh + (size_t)u * 512; const f32x4 k = *(const f32x4*)rp, v = *(const f32x4*)(rp + 256); sm_step(sa, qa, k, v, u <= t); sm_step(sb, qb, k, v, true); }
        sm_store(F, sa, 0, row0 + t); sm_store(F, sb, 0, row0 + t + 1);
    }
}
#ifndef PROBE_SITE
#define PROBE_SITE 0
#endif
#ifndef ATTN_SPLIT_WAVES
#define ATTN_SPLIT_WAVES 0
#endif
#ifndef PROMPT_EVEN_UNITS
#define PROMPT_EVEN_UNITS 0
#endif
DI void conv_phase(Frame& F, const Ins& I, int ei);
DI void attn_phase_v2(Frame& F, const Ins& I, int ei) {
    PH_IDS(F);
    constexpr int NSU = NB_S * 16, NPU = NB_P * 3 * 4 * 128;
    const bool oddwg = ((int)blockIdx.x & 1) != 0;
    if (oddwg) { for (int u = F.gw; u < NSU; u += F.NGW) attn_sample_unit(F, I, u, ei); }
    conv_phase(F, I, ei);
    PH_IDS(F);
    if (!oddwg) { for (int u = F.gw; u < NSU; u += F.NGW) attn_sample_unit(F, I, u, ei); }
    LAS unsigned char* vl = F.lds + RING_OFF + F.wave * (32 * VROWB);
    for (int u = F.gw; u < NPU; u += F.NGW) attn_prompt_unit(F, u, vl);
}

DI void s5_local_phase(Frame& F, int oi) {
    PH_IDS(F);
    const bf16* XN = (const bf16*)(F.ws + WS_XN); const float* AB = (const float*)(F.ws + WS_S5AB) + (size_t)oi * 64 * 64 * 2; const float* BB = (const float*)(F.ws + WS_S5BB) + (size_t)oi * 64 * 64 * 32;
    float* E = (float*)(F.ws + WS_S5E);
    const int p = F.lane;
    for (int u = F.gw; u < NB_P * 32 * 64; u += F.NGW) {
        const int g = u & 63, nc = u >> 6;
        const f32x2 ab = *(const f32x2*)(AB + ((size_t)g * 64 + p) * 2);
        float br[16], bi[16];
#pragma unroll
        for (int q = 0; q < 4; ++q) { const f32x4 a = *(const f32x4*)(BB + ((size_t)g * 64 + p) * 32 + 4 * q), b = *(const f32x4*)(BB + ((size_t)g * 64 + p) * 32 + 16 + 4 * q);
            br[4 * q] = a.x; br[4 * q + 1] = a.y; br[4 * q + 2] = a.z; br[4 * q + 3] = a.w; bi[4 * q] = b.x; bi[4 * q + 1] = b.y; bi[4 * q + 2] = b.z; bi[4 * q + 3] = b.w; }
        float hr = 0.f, hi = 0.f;
        const bf16* up = XN + (size_t)nc * 128 * D + 16 * g;
#pragma unroll 2
        for (int t = 0; t < 128; ++t) {
            const v4u ua = *(const v4u*)(up + (size_t)t * D), ub = *(const v4u*)(up + (size_t)t * D + 8);
            const float uu[16] = {bflo(ua.x), bfhi(ua.x), bflo(ua.y), bfhi(ua.y), bflo(ua.z), bfhi(ua.z), bflo(ua.w), bfhi(ua.w), bflo(ub.x), bfhi(ub.x), bflo(ub.y), bfhi(ub.y), bflo(ub.z), bfhi(ub.z), bflo(ub.w), bfhi(ub.w)};
            float sr = 0.f, si = 0.f;
#pragma unroll
            for (int c = 0; c < 16; ++c) { sr += br[c] * uu[c]; si += bi[c] * uu[c]; }
            const float nr = ab.x * hr - ab.y * hi + sr, ni = ab.x * hi + ab.y * hr + si; hr = nr; hi = ni;
        }
        *(f32x2*)(E + (((size_t)nc * 64 + g) * 64 + p) * 2) = (f32x2){hr, hi};
    }
}
DI void s5_carry_phase(Frame& F, int oi) {
    PH_IDS(F);
    const float* ABT = (const float*)(F.ws + WS_S5ABT) + (size_t)oi * 64 * 64 * 2; const float* E = (const float*)(F.ws + WS_S5E); float* SIN = (float*)(F.ws + WS_S5SIN);
    const int gt = F.gw * 64 + F.lane;
    if (gt < NB_P * 64 * 64) {
        const int n = gt >> 12, gp = gt & 4095;
        const f32x2 a = *(const f32x2*)(ABT + (size_t)gp * 2);
        f32x2 e[32];
#pragma unroll
        for (int c = 0; c < 32; ++c) e[c] = *(const f32x2*)(E + (((size_t)(n * 32 + c)) * 4096 + gp) * 2);
        float sr, si; asm volatile("v_mov_b32 %0, 0\n\tv_mov_b32 %1, 0" : "=v"(sr), "=v"(si));
#pragma unroll
        for (int c = 0; c < 32; ++c) { const size_t o = (((size_t)(n * 32 + c)) * 4096 + gp) * 2;
            *(f32x2*)(SIN + o) = (f32x2){sr, si};
            const float nr = a.x * sr - a.y * si + e[c].x, ni = a.x * si + a.y * sr + e[c].y; sr = nr; si = ni; }
        *(f32x2*)(F.out + O_S5P + ((size_t)(oi * NB_P + n) * 4096 + gp) * 2) = (f32x2){sr, si};
    }
}
DI void s5_out_phase(Frame& F, const Ins& I, int oi) {
    PH_IDS(F);
    const bf16* XN = (const bf16*)(F.ws + WS_XN); bf16* ZZ = (bf16*)(F.ws + WS_ZZ);
    const float* AB = (const float*)(F.ws + WS_S5AB) + (size_t)oi * 64 * 64 * 2; const float* BB = (const float*)(F.ws + WS_S5BB) + (size_t)oi * 64 * 64 * 32; const float* SIN = (const float*)(F.ws + WS_S5SIN);
    const float* Cr = I.p[24] + (size_t)oi * 64 * 16 * 64; const float* Ci = I.p[25] + (size_t)oi * 64 * 16 * 64; const float* Dk = I.p[26] + (size_t)oi * D;
    LAS float* hs = (LAS float*)(F.lds + RING_OFF + F.wave * 1024);
    const int p = F.lane, hch = F.lane >> 2, q = F.lane & 3;
    constexpr int NPU = NB_P * 32 * 64, NSU = NB_S * 64;
    for (int u = F.gw; u < NPU + NSU; u += F.NGW) {
        int g, row0, T; f32x2 h0;
        if (u < NPU) { g = u & 63; const int nc = u >> 6; row0 = nc * 128; T = 128; h0 = *(const f32x2*)(SIN + (((size_t)nc * 64 + g) * 64 + p) * 2); }
        else { const int v = u - NPU; g = v & 63; const int n = v >> 6; row0 = MP + n * 8; T = 8; h0 = *(const f32x2*)(I.p[6] + (((size_t)(oi * NB_S + n) * 64 + g) * 64 + p) * 2); }
        const f32x2 ab = *(const f32x2*)(AB + ((size_t)g * 64 + p) * 2);
        float br[16], bi[16], cr[16], ci[16];
#pragma unroll
        for (int k = 0; k < 4; ++k) { const f32x4 a = *(const f32x4*)(BB + ((size_t)g * 64 + p) * 32 + 4 * k), b = *(const f32x4*)(BB + ((size_t)g * 64 + p) * 32 + 16 + 4 * k);
            br[4 * k] = a.x; br[4 * k + 1] = a.y; br[4 * k + 2] = a.z; br[4 * k + 3] = a.w; bi[4 * k] = b.x; bi[4 * k + 1] = b.y; bi[4 * k + 2] = b.z; bi[4 * k + 3] = b.w;
            const f32x4 c = *(const f32x4*)(Cr + ((size_t)g * 16 + hch) * 64 + 16 * q + 4 * k), d = *(const f32x4*)(Ci + ((size_t)g * 16 + hch) * 64 + 16 * q + 4 * k);
            cr[4 * k] = c.x; cr[4 * k + 1] = c.y; cr[4 * k + 2] = c.z; cr[4 * k + 3] = c.w; ci[4 * k] = d.x; ci[4 * k + 1] = d.y; ci[4 * k + 2] = d.z; ci[4 * k + 3] = d.w; }
        const float dsk = Dk[16 * g + hch];
        float hr = h0.x, hi = h0.y;
        const bf16* up = XN + (size_t)row0 * D + 16 * g;
        for (int t = 0; t < T; ++t) {
            const v4u ua = *(const v4u*)(up + (size_t)t * D), ub = *(const v4u*)(up + (size_t)t * D + 8);
            const float uu[16] = {bflo(ua.x), bfhi(ua.x), bflo(ua.y), bfhi(ua.y), bflo(ua.z), bfhi(ua.z), bflo(ua.w), bfhi(ua.w), bflo(ub.x), bfhi(ub.x), bflo(ub.y), bfhi(ub.y), bflo(ub.z), bfhi(ub.z), bflo(ub.w), bfhi(ub.w)};
            const float um = bf2f(up[(size_t)t * D + hch]);
            float sr = 0.f, si = 0.f;
#pragma unroll
            for (int c = 0; c < 16; ++c) { sr += br[c] * uu[c]; si += bi[c] * uu[c]; }
            const float nr = ab.x * hr - ab.y * hi + sr, ni = ab.x * hi + ab.y * hr + si; hr = nr; hi = ni;
            hs[p] = hr; hs[64 + p] = hi;
            LDS_WAIT();
            float y = 0.f;
#pragma unroll
            for (int k = 0; k < 4; ++k) { const f32x4 a = *(const LAS f32x4*)(hs + 16 * q + 4 * k), b = *(const LAS f32x4*)(hs + 64 + 16 * q + 4 * k);
                y += cr[4 * k] * a.x + cr[4 * k + 1] * a.y + cr[4 * k + 2] * a.z + cr[4 * k + 3] * a.w;
                y -= ci[4 * k] * b.x + ci[4 * k + 1] * b.y + ci[4 * k + 2] * b.z + ci[4 * k + 3] * b.w; }
            LDS_WAIT();
            y += shx<1>(y); y += shx<2>(y);
            if (q == 0) { const float z = gelu_tanh(y + dsk * um); ZZ[(size_t)(row0 + t) * D + 16 * g + hch] = (bf16)f2bf(z); }
        }
        if (u >= NPU) { const int v = u - NPU, n = v >> 6; *(f32x2*)(F.out + O_S5S + (((size_t)(oi * NB_S + n) * 64 + g) * 64 + p) * 2) = (f32x2){hr, hi}; }
    }
}

constexpr size_t WS_S5BF = WS_END;
constexpr size_t WS_S5CF = WS_S5BF + 512 * 1024;
constexpr size_t WS_S5DF = WS_S5CF + 1 * MiB;
constexpr size_t WS_PART = WS_S5DF + 256 * 1024;
constexpr size_t WS_PART2 = WS_PART + 44 * MiB;
constexpr size_t XNSZ = 34 * MiB, WS_XNB = WS_PART2 + 32 * MiB;
constexpr size_t WS_END2 = WS_XNB + 8 * XNSZ;
static_assert((size_t)M * D * 2 == XNSZ, "XN buffer size");

DI void s5_tables_bf16(Frame& F, const Ins& I) {
    bf16* BF = (bf16*)(F.ws + WS_S5BF); bf16* CF = (bf16*)(F.ws + WS_S5CF); bf16* DF = (bf16*)(F.ws + WS_S5DF);
    const int gt = F.gw * 64 + F.lane, NGT = F.NGW * 64;
    for (int i = gt; i < 2 * 64 * 4 * 64; i += NGT) {
        const int ln = i & 63, T = (i >> 6) & 3, og = i >> 8, ph = T >> 1, ri = T & 1, p = 32 * ph + (ln & 31), h2 = ln >> 5;
        const int ip = og * 64 + p;
        const double lr = I.p[19][ip], li = I.p[20][ip], dt = exp_small((double)I.p[21][og]);
        const double mag = exp_small(lr * dt); double sn, cs; sincos_d(li * dt, sn, cs);
        const double abr = mag * cs, abi = mag * sn, den = lr * lr + li * li, nr = abr - 1.0;
        const double fr_ = (nr * lr + abi * li) / den, fi_ = (abi * lr - nr * li) / den;
        unsigned w[4];
#pragma unroll
        for (int jj = 0; jj < 8; jj += 2) { float v[2];
#pragma unroll
            for (int e = 0; e < 2; ++e) { const int ch = 8 * h2 + jj + e; const double br = I.p[22][(size_t)ip * 16 + ch], bi = I.p[23][(size_t)ip * 16 + ch]; v[e] = (float)(ri == 0 ? fr_ * br - fi_ * bi : fr_ * bi + fi_ * br); }
            w[jj >> 1] = pk2(v[0], v[1]); }
        *(v4u*)(BF + (size_t)i * 8) = (v4u){w[0], w[1], w[2], w[3]};
    }
    for (int i = gt; i < 2 * 64 * 8 * 64; i += NGT) {
        const int ln = i & 63, s = (i >> 6) & 7, og = i >> 9, n = ln & 31, h2 = ln >> 5;
        unsigned w[4];
#pragma unroll
        for (int jj = 0; jj < 8; jj += 2) { float v[2];
#pragma unroll
            for (int e = 0; e < 2; ++e) { const int kk = 16 * s + 8 * h2 + jj + e, T = kk >> 5, c = kk & 31, ph = T >> 1, ri = T & 1; float x = 0.f;
                if (n < 16) { const size_t ci = ((size_t)og * 16 + n) * 64 + 32 * ph + c; x = ri == 0 ? I.p[24][ci] : -I.p[25][ci]; }
                v[e] = x; }
            w[jj >> 1] = pk2(v[0], v[1]); }
        *(v4u*)(CF + (size_t)i * 8) = (v4u){w[0], w[1], w[2], w[3]};
    }
    for (int i = gt; i < 2 * 64 * 2 * 64; i += NGT) {
        const int ln = i & 63, hl = (i >> 6) & 1, og = i >> 7, n = ln & 31, h2 = ln >> 5;
        unsigned w[4];
#pragma unroll
        for (int jj = 0; jj < 8; jj += 2) { float v[2];
#pragma unroll
            for (int e = 0; e < 2; ++e) { const int ch = 8 * h2 + jj + e; float x = 0.f;
                if (n < 16 && ch == n) { const float d = I.p[26][(size_t)og * 16 + n]; const float dh = bf2f(f2bf(d)); x = hl == 0 ? dh : d - dh; }
                v[e] = x; }
            w[jj >> 1] = pk2(v[0], v[1]); }
        *(v4u*)(DF + (size_t)i * 8) = (v4u){w[0], w[1], w[2], w[3]};
    }
}

DI int s5_step_of_row(int i) { return (i & 3) + 4 * (i >> 3); }
DI void s5_scan16(f32x16& br, f32x16& bi, const f32x2 a, float& hr, float& hi) {
#pragma unroll
    for (int r = 0; r < 16; ++r) { const float nr = a.x * hr - a.y * hi + br[r], ni = a.x * hi + a.y * hr + bi[r]; hr = nr; hi = ni; br[r] = nr; bi[r] = ni; }
}
DI f32x16 zero16() { f32x16 z;
#pragma unroll
    for (int i = 0; i < 16; ++i) z[i] = 0.f;
    return z; }

template <class T> DI T ldg(const char* ubase, unsigned voff) { return *(const T*)(ubase + voff); }
DI void s5_local_phase2(Frame& F, int oi) {
    PH_IDS(F);
    const char* XNc = (const char*)(F.ws + WS_XNB + (size_t)(4 * oi + 2) * XNSZ);
    const char* ABc = (const char*)(F.ws + WS_S5AB) + (size_t)oi * 64 * 64 * 8; char* Ec = (char*)(F.ws + WS_S5E);
    const char* BFc = (const char*)(F.ws + WS_S5BF) + (size_t)oi * 64 * 4 * 64 * 16;
    const int lane = F.lane, c = lane & 31, h2 = lane >> 5;
    const int arow_seg = (c >> 2) & 1, arow_step = s5_step_of_row(c);
    const unsigned o_frag = lane * 16, o_c8 = c * 8, o_c8seg = c * 8 + h2 * (64 * 64 * 8), o_arow = ((arow_seg * 128 + arow_step) * D + 8 * h2) * 2;
    constexpr int NU = NB_P * 64 * 16;
    auto xbase = [&](int uu) { const int g = uu & 63, k = (uu >> 6) & 15, n = uu >> 10; return XNc + (((size_t)n * SEQ + (size_t)k * 256) * D + 16 * g) * 2; };
    bf16x8 afq[8], bf[4]; f32x2 a0 = (f32x2){0.f, 0.f}, a1 = (f32x2){0.f, 0.f}; int gcur = -1;
    if (F.gw < NU) { const char* xb = xbase(F.gw);
#pragma unroll
        for (int b = 0; b < 8; ++b) afq[b] = ldg<bf16x8>(xb + (size_t)b * (16 * D * 2), o_arow); }
    for (int u = F.gw; u < NU; u += F.NGW) {
        const int g = u & 63, k = (u >> 6) & 15, n = u >> 10;
        if (g != gcur) { gcur = g; const char* bfb = BFc + (size_t)g * (4 * 64 * 16);
#pragma unroll
            for (int T = 0; T < 4; ++T) bf[T] = ldg<bf16x8>(bfb + T * 1024, o_frag);
            const char* abb = ABc + (size_t)g * 512; a0 = ldg<f32x2>(abb, o_c8); a1 = ldg<f32x2>(abb + 256, o_c8); }
        bf16x8 af[8];
#pragma unroll
        for (int b = 0; b < 8; ++b) af[b] = afq[b];
        if (u + F.NGW < NU) { const char* xb = xbase(u + F.NGW);
#pragma unroll
            for (int b = 0; b < 8; ++b) afq[b] = ldg<bf16x8>(xb + (size_t)b * (16 * D * 2), o_arow); }
        float hr0 = 0.f, hi0 = 0.f, hr1 = 0.f, hi1 = 0.f;
#pragma unroll
        for (int blk = 0; blk < 8; ++blk) {
            f32x16 r0 = MFMA32(af[blk], bf[0], zero16()), i0 = MFMA32(af[blk], bf[1], zero16()), r1 = MFMA32(af[blk], bf[2], zero16()), i1 = MFMA32(af[blk], bf[3], zero16());
            s5_scan16(r0, i0, a0, hr0, hi0); s5_scan16(r1, i1, a1, hr1, hi1);
        }
        char* eb = Ec + (((size_t)(n * 32 + 2 * k) * 64 + g) * 64) * 8;
        st8_wt(eb + o_c8seg, __builtin_bit_cast(unsigned, hr0), __builtin_bit_cast(unsigned, hi0)); st8_wt(eb + 256 + o_c8seg, __builtin_bit_cast(unsigned, hr1), __builtin_bit_cast(unsigned, hi1));
    }
}

DI void s5_out_phase2(Frame& F, const Ins& I, int oi) {
    PH_IDS(F);
    const char* XNc = (const char*)(F.ws + WS_XNB + (size_t)(4 * oi + 2) * XNSZ);
    char* ZZc = (char*)(F.ws + WS_ZZ);
    const char* ABc = (const char*)(F.ws + WS_S5AB) + (size_t)oi * 64 * 64 * 8; const char* Ec = (const char*)(F.ws + WS_S5E); const char* ABTc = (const char*)(F.ws + WS_S5ABT) + (size_t)oi * 64 * 64 * 8; char* SPc = (char*)(F.out + O_S5P) + (size_t)oi * NB_P * 64 * 64 * 8;
    const char* BFc = (const char*)(F.ws + WS_S5BF) + (size_t)oi * 64 * 4 * 64 * 16; const char* CFc = (const char*)(F.ws + WS_S5CF) + (size_t)oi * 64 * 8 * 64 * 16; const char* DFc = (const char*)(F.ws + WS_S5DF) + (size_t)oi * 64 * 2 * 64 * 16;
    const char* STi = (const char*)(I.p[6]) + (size_t)oi * NB_S * 64 * 64 * 8; char* STo = (char*)(F.out + O_S5S) + (size_t)oi * NB_S * 64 * 64 * 8;
    const int lane = F.lane, c = lane & 31, h2 = lane >> 5;
    const int arow_seg = (c >> 2) & 1, arow_step = s5_step_of_row(c);
    const int erow = lane >> 1, erow_seg = (erow >> 2) & 1, erow_step = s5_step_of_row(erow);
    LAS unsigned char* img = F.lds + RING_OFF + F.wave * 8192;
    const unsigned wimg = (unsigned)(size_t)img + (unsigned)(c * 64 + 8 * h2);
    const int q4 = (lane & 15) >> 2, p4 = lane & 3, blk16 = (lane >> 4) & 1;
    const unsigned rimg = (unsigned)(size_t)img + (unsigned)((8 * h2 + q4) * 64 + 8 * (4 * blk16 + p4));
    const unsigned yimg_w = (unsigned)(size_t)img + (unsigned)(c * 4 + 4 * h2 * 64), yimg_r = (unsigned)(size_t)img + (unsigned)(erow * 64 + (lane & 1) * 32);
    const unsigned o_frag = lane * 16, o_c8 = c * 8;
    const unsigned o_c8seg = c * 8 + h2 * (64 * 64 * 8), o_c8smp = c * 8 + h2 * (2 * 64 * 64 * 8);
    const unsigned o_arow_p = ((arow_seg * 128 + arow_step) * D + 8 * h2) * 2, o_arow_s = ((arow_seg * 16 + arow_step) * D + 8 * h2) * 2;
    const unsigned o_erow_p = ((erow_seg * 128 + erow_step) * D + 8 * (lane & 1)) * 2, o_erow_s = ((erow_seg * 16 + erow_step) * D + 8 * (lane & 1)) * 2;
    constexpr int NPU = NB_P * 64 * 16, NSU = (NB_S / 4) * 64;
    for (int u = F.gw; u < NPU + NSU; u += F.NGW) {
        const bool samp = u >= NPU;
        int g, nblk; const char* xb; char* zb; const char* sib; char* sob = nullptr; unsigned o_arow, o_erow, o_st;
        if (!samp) { g = u & 63; const int k = (u >> 6) & 15, n = u >> 10; nblk = 8;
            const size_t tb = (((size_t)n * SEQ + (size_t)k * 256) * D + 16 * g) * 2; xb = XNc + tb; zb = ZZc + tb;
            sib = nullptr; o_arow = o_arow_p; o_erow = o_erow_p; o_st = o_c8seg;
        } else { const int v = u - NPU; g = v & 63; const int tile = v >> 6; nblk = 1;
            const size_t tb = (((size_t)MP + (size_t)tile * 32) * D + 16 * g) * 2; xb = XNc + tb; zb = ZZc + tb;
            sib = STi + (((size_t)(4 * tile) * 64 + g) * 64) * 8; sob = STo + (((size_t)(4 * tile) * 64 + g) * 64) * 8; o_arow = o_arow_s; o_erow = o_erow_s; o_st = o_c8smp;
        }
        float hr0, hi0, hr1, hi1; int kfin = -1; char* spo = nullptr;
        if (samp) { const f32x2 s0 = ldg<f32x2>(sib, o_st), s1 = ldg<f32x2>(sib + 256, o_st); hr0 = s0.x; hi0 = s0.y; hr1 = s1.x; hi1 = s1.y; }
        else {
            const int k = (u >> 6) & 15, n = u >> 10, seg = 2 * k + h2; kfin = k; spo = SPc + (((size_t)n * 64 + g) * 64) * 8;
            const char* eb = Ec + (((size_t)(n * 32) * 64 + g) * 64) * 8; const char* abtb = ABTc + (size_t)g * 512;
            const f32x2 t0 = ldg<f32x2>(abtb, o_c8), t1 = ldg<f32x2>(abtb + 256, o_c8);
            hr0 = 0.f; hi0 = 0.f; hr1 = 0.f; hi1 = 0.f;
#pragma unroll
            for (int half = 0; half < 2; ++half) {
                f32x2 e0[16], e1[16];
#pragma unroll
                for (int q = 0; q < 16; ++q) { const int cc = 16 * half + q < 31 ? 16 * half + q : 30; e0[q] = ldg<f32x2>(eb + (size_t)cc * (64 * 64 * 8), o_c8); e1[q] = ldg<f32x2>(eb + (size_t)cc * (64 * 64 * 8) + 256, o_c8); }
#pragma unroll
                for (int q = 0; q < 16; ++q) { const int cc = 16 * half + q;
                    if (cc < seg) { const float n0r = t0.x * hr0 - t0.y * hi0 + e0[q].x, n0i = t0.x * hi0 + t0.y * hr0 + e0[q].y, n1r = t1.x * hr1 - t1.y * hi1 + e1[q].x, n1i = t1.x * hi1 + t1.y * hr1 + e1[q].y;
                        hr0 = n0r; hi0 = n0i; hr1 = n1r; hi1 = n1i; } }
            }
        }
        const char* bfb = BFc + (size_t)g * (4 * 64 * 16); const char* cfb = CFc + (size_t)g * (8 * 64 * 16); const char* dfb = DFc + (size_t)g * (2 * 64 * 16);
        bf16x8 bf[4], cf[8], df[2];
#pragma unroll
        for (int T = 0; T < 4; ++T) bf[T] = ldg<bf16x8>(bfb + T * 1024, o_frag);
#pragma unroll
        for (int s = 0; s < 8; ++s) cf[s] = ldg<bf16x8>(cfb + s * 1024, o_frag);
#pragma unroll
        for (int s = 0; s < 2; ++s) df[s] = ldg<bf16x8>(dfb + s * 1024, o_frag);
        const char* abb = ABc + (size_t)g * 512;
        const f32x2 a0 = ldg<f32x2>(abb, o_c8), a1 = ldg<f32x2>(abb + 256, o_c8);
        bf16x8 afn = ldg<bf16x8>(xb, o_arow);
        for (int blk = 0; blk < nblk; ++blk) {
            const bf16x8 af = afn; afn = ldg<bf16x8>(xb + (size_t)(blk + 1 < nblk ? blk + 1 : blk) * (16 * D * 2), o_arow);
#pragma unroll
            for (int ph = 0; ph < 2; ++ph) {
                const f32x16 br = MFMA32(af, bf[2 * ph], zero16()), bi = MFMA32(af, bf[2 * ph + 1], zero16());
                const f32x2 a = ph ? a1 : a0; float hr = ph ? hr1 : hr0, hi = ph ? hi1 : hi0;
                float xr[16], xi[16];
#pragma unroll
                for (int r = 0; r < 16; ++r) {
                    if (samp && r == 8) {
                        *(f32x2*)(sob + ph * 256 + o_st) = (f32x2){hr, hi};
                        const f32x2 s0 = ldg<f32x2>(sib + 64 * 64 * 8 + ph * 256, o_st); hr = s0.x; hi = s0.y; }
                    const float nr = a.x * hr - a.y * hi + br[r], ni = a.x * hi + a.y * hr + bi[r]; hr = nr; hi = ni; xr[r] = nr; xi[r] = ni;
                }
                if (samp) *(f32x2*)(sob + 64 * 64 * 8 + ph * 256 + o_st) = (f32x2){hr, hi};
                if (ph) { hr1 = hr; hi1 = hi; } else { hr0 = hr; hi0 = hi; }
#pragma unroll
                for (int q = 0; q < 4; ++q) { v2u w;
                    w.x = pg8::cvt_pk_bf16(xr[4 * q], xr[4 * q + 1]); w.y = pg8::cvt_pk_bf16(xr[4 * q + 2], xr[4 * q + 3]); *(LAS v2u*)(size_t)(wimg + (2 * ph) * 2048 + 16 * q) = w;
                    w.x = pg8::cvt_pk_bf16(xi[4 * q], xi[4 * q + 1]); w.y = pg8::cvt_pk_bf16(xi[4 * q + 2], xi[4 * q + 3]); *(LAS v2u*)(size_t)(wimg + (2 * ph + 1) * 2048 + 16 * q) = w; }
                __builtin_amdgcn_sched_barrier(0);
            }
            f32x16 y = MFMA32(af, df[0], zero16()); y = MFMA32(af, df[1], y);
#pragma unroll
            for (int hb = 0; hb < 4; ++hb) {
                s16x4 t[4];
                asm volatile("s_waitcnt lgkmcnt(0)\n\t"
                             "ds_read_b64_tr_b16 %0, %4\n\tds_read_b64_tr_b16 %1, %4 offset:256\n\tds_read_b64_tr_b16 %2, %4 offset:1024\n\tds_read_b64_tr_b16 %3, %4 offset:1280\n\t"
                             "s_waitcnt lgkmcnt(0)"
                             : "=&v"(t[0]), "=&v"(t[1]), "=&v"(t[2]), "=&v"(t[3]) : "v"(rimg + 2048 * hb) : "memory");
#pragma unroll
                for (int s = 0; s < 2; ++s) y = MFMA32(__builtin_shufflevector(t[2 * s], t[2 * s + 1], 0, 1, 2, 3, 4, 5, 6, 7), cf[2 * hb + s], y);
            }
            if (c < 16) {
#pragma unroll
                for (int r = 0; r < 16; ++r) *(LAS float*)(size_t)(yimg_w + (unsigned)(((r & 3) + 8 * (r >> 2)) * 64)) = y[r];
            }
            { f32x4 ya, yb;
              asm volatile("s_waitcnt lgkmcnt(0)\n\tds_read_b128 %0, %2\n\tds_read_b128 %1, %2 offset:16\n\ts_waitcnt lgkmcnt(0)" : "=&v"(ya), "=&v"(yb) : "v"(yimg_r) : "memory");
              f32x4 za, zb2;
#pragma unroll
              for (int e = 0; e < 4; ++e) { za[e] = gelu_tanh(ya[e]); zb2[e] = gelu_tanh(yb[e]); }
              *(v4u*)(zb + (size_t)blk * (16 * D * 2) + o_erow) = pack8(za, zb2); }
        }
        if (kfin == 15 && h2 == 1) { *(f32x2*)(spo + o_c8) = (f32x2){hr0, hi0}; *(f32x2*)(spo + 256 + o_c8) = (f32x2){hr1, hi1}; }
    }
}

#ifndef SITE_P0
#define SITE_P0 1
#endif
#ifndef SITE_ADA
#define SITE_ADA 1
#endif
#ifndef SITE_NORM
#define SITE_NORM 1
#endif
#ifndef SITE_IN
#define SITE_IN 1
#endif
#ifndef SITE_ATTN
#define SITE_ATTN 1
#endif
#ifndef SITE_CONV
#define SITE_CONV 1
#endif
#ifndef SITE_O
#define SITE_O 1
#endif
#ifndef SITE_S5A
#define SITE_S5A 1
#endif
#ifndef SITE_S5B
#define SITE_S5B 1
#endif
#ifndef SITE_S5C
#define SITE_S5C 1
#endif
#ifndef SITE_GLU
#define SITE_GLU 1
#endif
#ifndef SITE_UP
#define SITE_UP 1
#endif
#ifndef SITE_DOWN
#define SITE_DOWN 1
#endif
#ifndef SITE_FINAL
#define SITE_FINAL 1
#endif
#ifndef PROBE_SITE
#define PROBE_SITE 0
#endif
#define REP(id) _Pragma("unroll 1") for (int rep_ = 0; rep_ < ((PROBE_SITE == (id)) ? 2 : 1); ++rep_)
#ifndef GEMM_ALIGN
#define GEMM_ALIGN true
#endif
#ifndef GEMM_SP2
#define GEMM_SP2 true
#endif
#ifndef S5_FUSED
#define S5_FUSED 0
#endif
#ifndef USE_SPLITK
#define USE_SPLITK 1
#endif
constexpr int NPHASES = 35;
#ifndef MK_PER_PHASE
#define MK_PER_PHASE 0
#endif
struct Args { Ins in; float* out; unsigned char* ws; int ph_lo, ph_hi; };
static_assert(sizeof(Args) == 32 * 8 + 8 + 8 + 8, "Args has no padding");

DI bool in_phase(int lo, int hi, int k) { asm volatile("" : "+s"(lo), "+s"(hi)); return lo <= k && k < hi; }
__global__ void __launch_bounds__(NWAVES * 64, 2) trunk_fwd(Args args) {
    extern __shared__ __attribute__((aligned(16))) unsigned char lds[];
    Frame F;
    F.lds = (LAS unsigned char*)lds;
    F.MISC = (volatile LAS unsigned*)(F.lds + MISC_OFF);
    F.wave = __builtin_amdgcn_readfirstlane((int)threadIdx.x >> 6);
    F.G = gridDim.x; F.NGW = F.G * NWAVES;
    F.ws = uni_ptr(args.ws); F.out = uni_ptr(args.out); F.ctl = (gu32*)(F.ws + WS_CTL); PH_IDS(F);
    const Ins& I = args.in;
    for (int u = F.tid; u < (LDS_BYTES - LDSCTL_OFF) / 4; u += NWAVES * 64) ((LAS unsigned*)(F.lds + LDSCTL_OFF))[u] = 0u;
    __syncthreads();
    XcdBarrier bar; bar.bar = (unsigned*)(F.ctl + CW_BAR); bar.x = 0; bar.st = nullptr;
    if (!MK_PER_PHASE) bar = xcd_barrier_post((unsigned*)(F.ctl + CW_BAR), F.MISC + 8);
    const int lo = args.ph_lo, hi = args.ph_hi;
#define IN(k) in_phase(lo, hi, (k))
#ifndef PROBE_SKIP
#define PROBE_SKIP 0
#endif
#define INL(kk) (IN(base + (kk)) && !(li < 0 && ((PROBE_SKIP >> (kk)) & 1)))
#define SEAM1(k, k2) do { if (IN(k) && IN(k2)) { PH_IDS(F); if (MK_PER_PHASE) { if (F.tid == 0) __hip_atomic_store(F.ctl + CW_TMO, 0xBADBA0u, RLX_AGENT); } else xcd_barrier(bar, false, false); } } while (0)
#define SEAMX(k, wb) do { if (IN(k) && IN((k) + 1)) { PH_IDS(F); if (MK_PER_PHASE) { if (F.tid == 0) __hip_atomic_store(F.ctl + CW_TMO, 0xBADBA0u, RLX_AGENT); } else { xcd_barrier(bar, false, wb); if (PROBE_SITE == 13) xcd_barrier(bar); } } } while (0)
#define SEAM(k) SEAMX(k, true)
#define SEAM_WT(k) SEAMX(k, false)
#define WSB(off) (F.ws + (off))
#define XN1p ((bf16*)WSB(WS_XNB + (size_t)(2 * l) * XNSZ))
#define XN2p ((bf16*)WSB(WS_XNB + (size_t)(2 * l + 1) * XNSZ))
#define Xp ((bf16*)WSB(WS_X))
#define XSRC_P (l == 0 ? (const void*)I.p[0] : (const void*)Xp)
#define XSRC_S (l == 0 ? (const void*)I.p[1] : (const void*)(Xp + (size_t)MP * D))
#define MODL ((float*)WSB(WS_MOD) + (size_t)l * 6144)

    if (SITE_P0 && IN(0)) REP(1) { p0_prologue(F, I); s5_tables_bf16(F, I); } SEAM(0);
    if (SITE_ADA && IN(1)) { PH_IDS(F);
        pg8::Gemm g{(const pg8::bf16_t*)WSB(WS_SILC), (const pg8::bf16_t*)WSB(WS_WADA), 256, MODLD, D, D}; pg8::StaticOrder S; S.init(256, MODLD, F.G, (int)blockIdx.x);
        EpiMod E{(float*)WSB(WS_MOD), I.p[12]};
        pg8::gemm_phase<EpiMod, pg8::StaticOrder, GEMM_ALIGN, GEMM_SP2>(F.lds + RING_OFF, g, S, E, F.wave);
        { PH_IDS(F);
          constexpr int NCONV = P0_NITEMS - P0_ADA_ITEMS - P0_DEFER, NB = 4096, NA = NCONV - NB, NADA = MODLD / 256;
          const int bx = (int)blockIdx.x, nfree = F.G - NADA;
          if (nfree > 0) { if (bx >= NADA) p0_items(F, I, 0, NA, (bx - NADA) * NWAVES + F.wave, nfree * NWAVES); else p0_items(F, I, NA, NCONV, bx * NWAVES + F.wave, NADA * NWAVES); }
          else p0_items(F, I, 0, NCONV, F.gw, F.NGW); }
    } SEAM(1);

    for (int li = (PROBE_SITE == 20 ? -1 : 0); li < 4; ++li) {
        const int l = li < 0 ? 0 : li;
        const int base = 2 + 8 * l, hl = l >> 1;
        if (SITE_NORM && INL(0)) REP(2) { PH_IDS(F); norm_phase<false>(F, XSRC_P, XSRC_S, l == 0, I.p[9] + (size_t)(l * 2 + 0) * D, MODL + 0 * D, MODL + 1 * D, XN1p, nullptr, (const float*)WSB(WS_PART), (l == 0 || !USE_SPLITK) ? 0 : FF / 256, MODL - 6144 + 5 * D, Xp); }
        SEAM_WT(base + 0);
        if ((l & 1) == 0) {
            if (SITE_IN && INL(1)) REP(3) { PH_IDS(F);
                pg8::Gemm g{XN1p, (const pg8::bf16_t*)WSB(WS_WIN) + (size_t)hl * INC * D, M, INC, D, D}; pg8::StaticOrder S; S.init(M, INC, F.G, (int)blockIdx.x);
                EpiIn E{(bf16*)WSB(WS_U), (bf16*)WSB(WS_Q), (const float*)WSB(WS_ROPE), F.out, hl};
                pg8::gemm_phase<EpiIn, pg8::StaticOrder, GEMM_ALIGN, GEMM_SP2>(F.lds + RING_OFF, g, S, E, F.wave);
                if (l == 0 && PROBE_SITE != 3) {
                    PH_IDS(F);
                    constexpr int NU = (M / 256) * (INC / 256); const int nfull = NU % F.G, bx = (int)blockIdx.x;
                    constexpr int D0 = P0_NITEMS - P0_ADA_ITEMS - P0_DEFER, D1 = P0_NITEMS - P0_ADA_ITEMS;
                    if (nfull > 0 && nfull < F.G) { if (bx >= nfull) p0_items(F, I, D0, D1, (bx - nfull) * NWAVES + F.wave, (F.G - nfull) * NWAVES); }
                    else p0_items(F, I, D0, D1, F.gw, F.NGW);
                }
            } SEAM(base + 1);
            if (SITE_ATTN && INL(2)) REP(4) attn_phase_v2(F, I, hl);
            SEAM(base + 2);
            if (SITE_CONV && INL(3)) REP(5) { merge_rows(F); }
            SEAM_WT(base + 3);
            if (SITE_O && INL(4)) { PH_IDS(F);
                { pg8::Gemm g{(const pg8::bf16_t*)WSB(WS_MIX), (const pg8::bf16_t*)WSB(WS_WO) + (size_t)hl * D * MIXK, USE_SPLITK ? MP : M, D, MIXK, MIXK}; pg8::StaticOrder S; S.init(USE_SPLITK ? MP : M, D, F.G, (int)blockIdx.x);
                  EpiResid E{XSRC_P, XSRC_S, l == 0, Xp, MODL + 2 * D};
                  pg8::gemm_phase<EpiResid, pg8::StaticOrder, GEMM_ALIGN, GEMM_SP2>(F.lds + RING_OFF, g, S, E, F.wave); }
                if (USE_SPLITK) { PH_IDS(F);
                  pg8::Gemm g{(const pg8::bf16_t*)WSB(WS_MIX), (const pg8::bf16_t*)WSB(WS_WO) + (size_t)hl * D * MIXK, M, D, MIXK, 256}; pg8::SplitOrder S; S.init(MP / 256, MS / 256, D, MIXK / 256, 256, F.G, (int)blockIdx.x);
                  EpiPartial E{(float*)WSB(WS_PART2), D};
                  pg8::gemm_phase<EpiPartial, pg8::SplitOrder, GEMM_ALIGN, GEMM_SP2>(F.lds + RING_OFF, g, S, E, F.wave); }
            } SEAM(base + 4);
        } else {
#if S5_FUSED
            if (SITE_S5C && INL(1)) REP(7) s5_fused_phase_DISABLED(F, I, hl);
            SEAM1(base + 1, base + 4);
#else
            if (SITE_S5A && INL(1)) REP(6) s5_local_phase2(F, hl);
            SEAM1(base + 1, base + 3);
            if (SITE_S5C && INL(3)) REP(7) s5_out_phase2(F, I, hl);
            SEAM(base + 3);
#endif
            if (SITE_GLU && INL(4)) { PH_IDS(F);
                { pg8::Gemm g{(const pg8::bf16_t*)WSB(WS_ZZ), (const pg8::bf16_t*)WSB(WS_WGLU) + (size_t)hl * 2 * D * D, USE_SPLITK ? MP : M, 2 * D, D, D}; pg8::StaticOrder S; S.init(USE_SPLITK ? MP : M, 2 * D, F.G, (int)blockIdx.x);
                  EpiGLU E{Xp, MODL + 2 * D, I.p[28] + (size_t)hl * 2 * D};
                  pg8::gemm_phase<EpiGLU, pg8::StaticOrder, GEMM_ALIGN, GEMM_SP2>(F.lds + RING_OFF, g, S, E, F.wave); }
                if (USE_SPLITK) { PH_IDS(F);
                  pg8::Gemm g{(const pg8::bf16_t*)WSB(WS_ZZ), (const pg8::bf16_t*)WSB(WS_WGLU) + (size_t)hl * 2 * D * D, M, 2 * D, D, 256}; pg8::SplitOrder S; S.init(MP / 256, MS / 256, 2 * D, D / 256, 256, F.G, (int)blockIdx.x);
                  EpiPartial E{(float*)WSB(WS_PART2), 2 * D};
                  pg8::gemm_phase<EpiPartial, pg8::SplitOrder, GEMM_ALIGN, GEMM_SP2>(F.lds + RING_OFF, g, S, E, F.wave); }
            } SEAM(base + 4);
        }
        _Pragma("unroll 1") for (int rp_ = 0; rp_ < (PROBE_SITE == 21 ? 2 : 1); ++rp_) {
        if (SITE_NORM && INL(5)) REP(2) { PH_IDS(F); norm_phase<false>(F, Xp, ((l & 1) == 0 && USE_SPLITK) ? XSRC_S : (const void*)(Xp + (size_t)MP * D), (l == 0 && USE_SPLITK) ? 2 : 0, I.p[9] + (size_t)(l * 2 + 1) * D, MODL + 3 * D, MODL + 4 * D, XN2p, nullptr, (const float*)WSB(WS_PART2), !USE_SPLITK ? 0 : ((l & 1) == 0 ? MIXK / 256 : D / 256), MODL + 2 * D, Xp, (l & 1) ? I.p[28] + (size_t)hl * 2 * D : nullptr); }
        SEAM_WT(base + 5);
        if (SITE_UP && INL(6)) REP(8) { PH_IDS(F);
            pg8::Gemm g{XN2p, (const pg8::bf16_t*)WSB(WS_WGU) + (size_t)l * 2 * FF * D, M, 2 * FF, D, D}; pg8::StaticOrder S; S.init(M, 2 * FF, F.G, (int)blockIdx.x);
            EpiSwiGLU E{(bf16*)WSB(WS_ACT)};
            pg8::gemm_phase<EpiSwiGLU, pg8::StaticOrder, GEMM_ALIGN, GEMM_SP2>(F.lds + RING_OFF, g, S, E, F.wave);
        } SEAM(base + 6);
        }
        if (SITE_DOWN && INL(7)) { PH_IDS(F);
            { pg8::Gemm g{(const pg8::bf16_t*)WSB(WS_ACT), (const pg8::bf16_t*)WSB(WS_WD) + (size_t)l * D * FF, USE_SPLITK ? MP : M, D, FF, FF}; pg8::StaticOrder S; S.init(USE_SPLITK ? MP : M, D, F.G, (int)blockIdx.x);
              EpiResid E{Xp, Xp + (size_t)MP * D, 0, Xp, MODL + 5 * D};
              pg8::gemm_phase<EpiResid, pg8::StaticOrder, GEMM_ALIGN, GEMM_SP2>(F.lds + RING_OFF, g, S, E, F.wave); }
            if (USE_SPLITK) { PH_IDS(F);
              pg8::Gemm g{(const pg8::bf16_t*)WSB(WS_ACT), (const pg8::bf16_t*)WSB(WS_WD) + (size_t)l * D * FF, M, D, FF, 256}; pg8::SplitOrder S; S.init(MP / 256, MS / 256, D, FF / 256, 256, F.G, (int)blockIdx.x);
              EpiPartial E{(float*)WSB(WS_PART), D};
              pg8::gemm_phase<EpiPartial, pg8::SplitOrder, GEMM_ALIGN, GEMM_SP2>(F.lds + RING_OFF, g, S, E, F.wave); }
        } SEAM(base + 7);
    }
    if (SITE_FINAL && IN(34)) { PH_IDS(F); const int l = 4; norm_phase<true>(F, Xp, Xp + (size_t)MP * D, 0, I.p[10], nullptr, nullptr, nullptr, F.out + O_YP, (const float*)WSB(WS_PART), USE_SPLITK ? FF / 256 : 0, MODL - 6144 + 5 * D, Xp); }
#undef IN
#undef SEAM
}

extern "C" void kernel_launch(void* const* d_in, const int* in_sizes, int n_in, void* d_out, int out_size, void* d_ws, size_t ws_size, hipStream_t stream) {
    static int grid = 0;
    if (grid == 0) {
        if (n_in != 32 || in_sizes[0] != MP * D || (size_t)out_size != O_END || ws_size < WS_END2) { fprintf(stderr, "kernel_launch: unexpected shapes (n_in %d, in0 %d, out %d, ws %zu); nothing launched\n", n_in, n_in > 0 ? in_sizes[0] : -1, out_size, ws_size); grid = -1; return; }
        int dev = 0, cus = 0, per_cu = 0;
        if (hipGetDevice(&dev) != hipSuccess || hipDeviceGetAttribute(&cus, hipDeviceAttributeMultiprocessorCount, dev) != hipSuccess) { grid = -1; return; }
        if (hipFuncSetAttribute((const void*)trunk_fwd, hipFuncAttributeMaxDynamicSharedMemorySize, LDS_BYTES) != hipSuccess) { fprintf(stderr, "kernel_launch: hipFuncSetAttribute failed\n"); grid = -1; return; }
        if (hipOccupancyMaxActiveBlocksPerMultiprocessor(&per_cu, (const void*)trunk_fwd, NWAVES * 64, LDS_BYTES) != hipSuccess || per_cu < 1) fprintf(stderr, "kernel_launch: occupancy query reports %d\n", per_cu);
        (void)hipGetLastError();
        grid = cus;
    }
    if (grid < 0) return;
    if (hipMemsetAsync((char*)d_ws + WS_CTL, 0, CTL_ZERO_BYTES, stream) != hipSuccess) return;
    Args a{};
    for (int i = 0; i < 32; ++i) a.in.p[i] = (const float*)d_in[i];
    a.out = (float*)d_out; a.ws = (unsigned char*)d_ws;
#if MK_PER_PHASE
    for (int k = 0; k < NPHASES; ++k) { a.ph_lo = k; a.ph_hi = k + 1; hipLaunchKernelGGL(trunk_fwd, dim3(grid), dim3(NWAVES * 64), LDS_BYTES, stream, a); }
#else
    a.ph_lo = 0; a.ph_hi = NPHASES;
    hipLaunchKernelGGL(trunk_fwd, dim3(grid), dim3(NWAVES * 64), LDS_BYTES, stream, a);
#endif
}
```
